# Optimizing an MI355X kernel written in HIP

```python
import jax, jax.numpy as jnp
from jax import lax
import numpy as np

D_MODEL = 2048
BATCH = 2
SEQ = 16384
DEPTH = 1

HEAD_DIM = 128
EPS = 1e-6
GDN_HEADS = 8
GDN_WIDTH = GDN_HEADS * HEAD_DIM
GDN_CONV = 4
GDN_CHUNK = 64
SWA_GROUPS = ((128, 1), (512, 4), (2048, 16))
SWA_HEADS_PER_GROUP = 4
SWA_HEADS = SWA_HEADS_PER_GROUP * len(SWA_GROUPS)
SWA_WIDTH = SWA_HEADS * HEAD_DIM
SWA_OUT_WIDTH = SWA_HEADS_PER_GROUP * HEAD_DIM
SWA_BLOCK = 128
ROPE_THETA = 10000.0
NEG_INF = -1e30
D_FF = 4 * D_MODEL
IN_SIZES = (3 * GDN_WIDTH, GDN_WIDTH, GDN_HEADS, GDN_HEADS, 3 * SWA_WIDTH, D_MODEL, D_MODEL)
IN_COLS = sum(IN_SIZES)

kernel_name = "hybrid_gdn_dilated_swa_block"


def _rmsnorm(x, w):
    x32 = x.astype(jnp.float32)
    y = x32 * lax.rsqrt(jnp.mean(jnp.square(x32), axis=-1, keepdims=True) + EPS)
    return (y * w.astype(jnp.float32)).astype(x.dtype)


def _l2norm(x):
    x32 = x.astype(jnp.float32)
    return x32 * lax.rsqrt(jnp.sum(jnp.square(x32), axis=-1, keepdims=True) + EPS)


def _split_cols(t):
    points, acc = [], 0
    for sz in IN_SIZES[:-1]:
        acc += sz
        points.append(acc)
    return jnp.split(t, points, axis=-1)


def _causal_conv(x, w):
    c = x.shape[-1]
    return lax.conv_general_dilated(
        x, w[:, None, :].astype(x.dtype), window_strides=(1,),
        padding=((GDN_CONV - 1, 0),), dimension_numbers=("NWC", "WIO", "NWC"),
        feature_group_count=c)


def _rope(x, positions):
    half = HEAD_DIM // 2
    inv_freq = ROPE_THETA ** (-jnp.arange(half, dtype=jnp.float32) / half)
    ang = positions.astype(jnp.float32)[..., None] * inv_freq
    cos = jnp.concatenate([jnp.cos(ang), jnp.cos(ang)], -1)[:, :, None, :]
    sin = jnp.concatenate([jnp.sin(ang), jnp.sin(ang)], -1)[:, :, None, :]
    x32 = x.astype(jnp.float32)
    rot = jnp.concatenate([-x32[..., half:], x32[..., :half]], -1)
    return (x32 * cos + rot * sin).astype(x.dtype)


def _gdn_chunked(q, k, v, g, beta):
    b, s, h, d = q.shape
    n = s // GDN_CHUNK

    def chunks(t):
        t = t.reshape((b, n, GDN_CHUNK, h) + t.shape[3:])
        return jnp.moveaxis(t, 3, 1)

    q, k, v, g, beta = (chunks(t) for t in (q, k, v, g, beta))
    G = jnp.cumsum(g, axis=-1)
    idx = jnp.arange(GDN_CHUNK)
    incl = idx[:, None] >= idx[None, :]
    strict = idx[:, None] > idx[None, :]
    diff = G[..., :, None] - G[..., None, :]
    decay = jnp.where(incl, jnp.exp(jnp.where(incl, diff, 0.0)), 0.0)
    k_beta = k * beta[..., None]
    a_kk = jnp.where(strict, jnp.einsum("bhnid,bhnjd->bhnij", k_beta, k) * decay, 0.0)
    eye = jnp.eye(GDN_CHUNK, dtype=q.dtype)
    rhs = jnp.concatenate([v * beta[..., None], k_beta * jnp.exp(G)[..., None]], axis=-1)
    sol = lax.linalg.triangular_solve(eye + a_kk, rhs, left_side=True, lower=True,
                                      unit_diagonal=True)
    u, w = sol[..., :d], sol[..., d:]
    a_qk = jnp.where(incl, jnp.einsum("bhnid,bhnjd->bhnij", q, k) * decay, 0.0)
    q_dec = q * jnp.exp(G)[..., None]
    g_last = G[..., -1]
    k_dec = k * jnp.exp(g_last[..., None] - G)[..., None]

    def step(state, inp):
        u_c, w_c, qd_c, aqk_c, kd_c, gl_c = inp
        v_new = u_c - jnp.einsum("bhcd,bhde->bhce", w_c, state)
        o_c = (jnp.einsum("bhcd,bhde->bhce", qd_c, state)
               + jnp.einsum("bhij,bhje->bhie", aqk_c, v_new))
        state = (state * jnp.exp(gl_c)[..., None, None]
                 + jnp.einsum("bhcd,bhce->bhde", kd_c, v_new))
        return state, o_c

    xs = tuple(jnp.moveaxis(t, 2, 0) for t in (u, w, q_dec, a_qk, k_dec, g_last))
    state0 = jnp.zeros((b, h, d, v.shape[-1]), q.dtype)
    _, o = lax.scan(step, state0, xs)
    o = jnp.moveaxis(o, 0, 2)
    return jnp.moveaxis(o, 1, 3).reshape(b, s, h, -1)


def _gdn_branch(qkv, z, a, bta, conv_w, a_log, dt_bias, norm_w):
    b, s, _ = qkv.shape
    qkv = jax.nn.silu(_causal_conv(qkv, conv_w))
    q, k, v = jnp.split(qkv, 3, axis=-1)
    q = _l2norm(q.reshape(b, s, GDN_HEADS, HEAD_DIM)) * (HEAD_DIM ** -0.5)
    k = _l2norm(k.reshape(b, s, GDN_HEADS, HEAD_DIM))
    v = v.reshape(b, s, GDN_HEADS, HEAD_DIM).astype(jnp.float32)
    beta = jax.nn.sigmoid(bta.astype(jnp.float32))
    g = -jnp.exp(a_log.astype(jnp.float32)) * jax.nn.softplus(
        a.astype(jnp.float32) + dt_bias.astype(jnp.float32))
    o = _gdn_chunked(q, k, v, g, beta)
    o = o * lax.rsqrt(jnp.mean(jnp.square(o), axis=-1, keepdims=True) + EPS)
    zh = z.reshape(b, s, GDN_HEADS, HEAD_DIM).astype(jnp.float32)
    o = o * norm_w.astype(jnp.float32) * jax.nn.silu(zh)
    return o.reshape(b, s, GDN_WIDTH).astype(qkv.dtype)


def _dilated_window_attention(q, k, v, n_back, dil):
    b, s, h, dh = q.shape
    L = s // dil
    nb = -(-L // SWA_BLOCK)
    Lp = nb * SWA_BLOCK

    def by_residue(t):
        t = t.reshape(b, L, dil, h, dh).transpose(0, 2, 1, 3, 4)
        t = jnp.pad(t, ((0, 0), (0, 0), (0, Lp - L), (0, 0), (0, 0)))
        return t.reshape(b, dil, nb, SWA_BLOCK, h, dh)

    def with_prev(t):
        prev = jnp.pad(t, ((0, 0), (0, 0), (1, 0), (0, 0), (0, 0), (0, 0)))[:, :, :-1]
        return jnp.concatenate([prev, t], axis=3)

    qb = by_residue(q)
    kk = with_prev(by_residue(k))
    vv = with_prev(by_residue(v))
    qi = jnp.arange(SWA_BLOCK)[:, None] + SWA_BLOCK
    kj = jnp.arange(2 * SWA_BLOCK)[None, :]
    dist = qi - kj
    blk = jnp.arange(nb)[:, None, None]
    valid = (dist >= 0) & (dist <= n_back) & ((blk - 1) * SWA_BLOCK + kj >= 0)
    scores = jnp.einsum("bdnqhc,bdnkhc->bdnhqk", qb, kk).astype(jnp.float32) * (HEAD_DIM ** -0.5)
    scores = jnp.where(valid[:, None], scores, NEG_INF)
    lse = jax.nn.logsumexp(scores, axis=-1)
    p = jnp.exp(scores - lse[..., None])
    o = jnp.einsum("bdnhqk,bdnkhc->bdnqhc", p.astype(v.dtype), vv)
    o = o.reshape(b, dil, Lp, h, dh)[:, :, :L].transpose(0, 2, 1, 3, 4).reshape(b, s, h, dh)
    lse = lse.transpose(0, 1, 2, 4, 3).reshape(b, dil, Lp, h)[:, :, :L]
    lse = lse.transpose(0, 2, 1, 3).reshape(b, s, h)
    return o, lse


def _swa_branch(qkv, positions, q_norm_w, k_norm_w):
    b, s, _ = qkv.shape
    q, k, v = jnp.split(qkv, 3, axis=-1)
    q = _rope(_rmsnorm(q.reshape(b, s, SWA_HEADS, HEAD_DIM), q_norm_w), positions)
    k = _rope(_rmsnorm(k.reshape(b, s, SWA_HEADS, HEAD_DIM), k_norm_w), positions)
    v = v.reshape(b, s, SWA_HEADS, HEAD_DIM)
    outs, lses = [], []
    for gi, (window, dil) in enumerate(SWA_GROUPS):
        hs = slice(gi * SWA_HEADS_PER_GROUP, (gi + 1) * SWA_HEADS_PER_GROUP)
        o, lse = _dilated_window_attention(q[:, :, hs], k[:, :, hs], v[:, :, hs], window // dil, dil)
        outs.append(o.astype(jnp.float32))
        lses.append(lse)
    wts = jax.nn.softmax(jnp.stack(lses), axis=0)
    o = jnp.sum(jnp.stack(outs) * wts[..., None], axis=0)
    return o.reshape(b, s, SWA_OUT_WIDTH).astype(qkv.dtype)


def setup_inputs(seed: int = 0) -> dict:
    key = jax.random.key(seed)
    ks = jax.random.split(key, 18)
    f32 = jnp.float32
    x = jax.random.normal(ks[0], (BATCH, SEQ, D_MODEL), f32)
    positions = jnp.broadcast_to(jnp.arange(SEQ, dtype=jnp.int32)[None, :], (BATCH, SEQ))
    ln1_w = 1.0 + 0.02 * jax.random.normal(ks[1], (DEPTH, D_MODEL), f32)
    w_in = jax.random.normal(ks[2], (DEPTH, D_MODEL, IN_COLS), f32) * D_MODEL ** -0.5
    gdn_conv_w = jax.random.normal(ks[3], (DEPTH, GDN_CONV, 3 * GDN_WIDTH), f32) * 0.5
    gdn_a_log = jnp.log(jax.random.uniform(ks[4], (DEPTH, GDN_HEADS), f32, 1.0, 16.0))
    dt = jnp.exp(jax.random.uniform(ks[5], (DEPTH, GDN_HEADS), f32, np.log(1e-3), np.log(1e-1)))
    gdn_dt_bias = dt + jnp.log(-jnp.expm1(-dt))
    gdn_norm_w = 1.0 + 0.02 * jax.random.normal(ks[6], (DEPTH, HEAD_DIM), f32)
    w_gdn_proj = jax.random.normal(ks[7], (DEPTH, GDN_WIDTH, D_MODEL), f32) * GDN_WIDTH ** -0.5
    swa_q_norm_w = 1.0 + 0.02 * jax.random.normal(ks[8], (DEPTH, HEAD_DIM), f32)
    swa_k_norm_w = 1.0 + 0.02 * jax.random.normal(ks[9], (DEPTH, HEAD_DIM), f32)
    w_swa_proj = jax.random.normal(ks[10], (DEPTH, SWA_OUT_WIDTH, D_MODEL), f32) * SWA_OUT_WIDTH ** -0.5
    w_out = jax.random.normal(ks[11], (DEPTH, D_MODEL, D_MODEL), f32) * D_MODEL ** -0.5
    ln2_w = 1.0 + 0.02 * jax.random.normal(ks[12], (DEPTH, D_MODEL), f32)
    w_ff1 = jax.random.normal(ks[13], (DEPTH, D_MODEL, D_FF), f32) * D_MODEL ** -0.5
    w_ff2 = jax.random.normal(ks[14], (DEPTH, D_FF, D_MODEL), f32) * D_FF ** -0.5
    return {"x": x, "positions": positions, "ln1_w": ln1_w, "w_in": w_in,
            "gdn_conv_w": gdn_conv_w, "gdn_a_log": gdn_a_log, "gdn_dt_bias": gdn_dt_bias,
            "gdn_norm_w": gdn_norm_w, "w_gdn_proj": w_gdn_proj,
            "swa_q_norm_w": swa_q_norm_w, "swa_k_norm_w": swa_k_norm_w,
            "w_swa_proj": w_swa_proj, "w_out": w_out, "ln2_w": ln2_w,
            "w_ff1": w_ff1, "w_ff2": w_ff2}


def reference(x, positions, ln1_w, w_in, gdn_conv_w, gdn_a_log, gdn_dt_bias, gdn_norm_w,
              w_gdn_proj, swa_q_norm_w, swa_k_norm_w, w_swa_proj, w_out, ln2_w, w_ff1, w_ff2):
    for l in range(DEPTH):
        h = _rmsnorm(x, ln1_w[l])
        proj = jnp.einsum("bsd,de->bse", h, w_in[l])
        gdn_qkv, gdn_z, gdn_a, gdn_b, swa_qkv, gate_a, gate_b = _split_cols(proj)
        o_a = _gdn_branch(gdn_qkv, gdn_z, gdn_a, gdn_b, gdn_conv_w[l], gdn_a_log[l],
                          gdn_dt_bias[l], gdn_norm_w[l])
        o_b = _swa_branch(swa_qkv, positions, swa_q_norm_w[l], swa_k_norm_w[l])
        y_a = jnp.einsum("bse,ed->bsd", o_a, w_gdn_proj[l])
        y_b = jnp.einsum("bse,ed->bsd", o_b, w_swa_proj[l])
        mixed = jax.nn.sigmoid(gate_a) * y_a + jax.nn.sigmoid(gate_b) * y_b
        x = x + jnp.einsum("bsd,de->bse", mixed, w_out[l])
        h = _rmsnorm(x, ln2_w[l])
        u = jax.nn.relu(jnp.einsum("bsd,df->bsf", h, w_ff1[l]))
        x = x + jnp.einsum("bsf,fd->bsd", jnp.square(u), w_ff2[l])
    return x
```

```cpp
#include <hip/hip_runtime.h>
#include <hip/hip_cooperative_groups.h>
#include <cstdio>
namespace cg = cooperative_groups;
namespace pg8 {
#define PG8_LAS __attribute__((address_space(3)))
typedef unsigned short bf16_t;
typedef short bf16x8 __attribute__((ext_vector_type(8)));
typedef float f32x4 __attribute__((ext_vector_type(4)));
typedef unsigned u32x4 __attribute__((ext_vector_type(4)));
constexpr int BM = 256, BK = 64, HALF = 128, HTB = HALF * BK * 2  , STAGE_BYTES = 8 * HTB, NXCD = 8, WGM = 8;

__host__ __device__ __forceinline__ int lds_byte(int r, int c) { const int st = (r >> 4) * 2 + (c >> 5), rr = r & 15, cc = c & 31, ob = rr * 64 + cc * 2; return st * 1024 + (ob ^ (((ob >> 9) & 1) << 5)); }
__host__ __device__ __forceinline__ void stage_rc(int b, int& R, int& C) { const int st = b / 1024, sb = b % 1024, swz = sb ^ (((sb >> 9) & 1) << 5); R = (st >> 1) * 16 + swz / 64; C = (st & 1) * 32 + (swz % 64) / 2; }
__host__ __device__ __forceinline__ int perm32(int rho) { const int n = rho >> 4, i = rho & 15; return 8 * (i >> 2) + 4 * n + (i & 3); }

struct Unit { int pm, pn; };
struct Gemm { const bf16_t* A; const bf16_t* Bt; int M, N, K; };

struct StaticOrder {
    int nM, nN, nwg, G, c;
    __host__ __device__ void init(int M, int N, int G_, int c_) { nM = M / BM; nN = N / BM; nwg = nM * nN; G = G_; c = c_; }
    __host__ __device__ bool next(int i, Unit& u) const {
        const long L = (long)i * G + c; if (L >= nwg) return false;
        int wgid = (int)L; { const int q = nwg / NXCD, r = nwg % NXCD, xcd = wgid % NXCD, off = wgid / NXCD; wgid = (xcd < r ? xcd * (q + 1) : r * (q + 1) + (xcd - r) * q) + off; }
        const int nig = WGM * nN, gid = wgid / nig, fm = gid * WGM, gsz = (nM - fm) < WGM ? (nM - fm) : WGM;
        u.pm = fm + ((wgid % nig) % gsz); u.pn = (wgid % nig) / gsz; return true;
    }
    __device__ __forceinline__ void a_ready(const Unit&) const {}
    __device__ __forceinline__ void done(const Unit&) const {}
};
__device__ __forceinline__ unsigned cvt_pk_bf16(float lo, float hi) { unsigned r; asm volatile("v_cvt_pk_bf16_f32 %0, %1, %2" : "=v"(r) : "v"(lo), "v"(hi)); return r; }
typedef float f32x2 __attribute__((ext_vector_type(2)));
template <class Epi, class Sched, bool STAMP = false>
__device__ __forceinline__ void gemm_phase(PG8_LAS unsigned char* lds, const Gemm g, const Sched& S, const Epi& E, unsigned long long* stamps) {
    const int tid = threadIdx.x, wid = __builtin_amdgcn_readfirstlane(tid >> 6), lane = tid & 63, wr = wid >> 2, wc = wid & 3, fr = lane & 15, fq = lane >> 4;
    const int K = g.K, nt = K / BK;
    int ts_lo = 0, ts_hi = 0, nts = 0; const unsigned long long rt_entry = STAMP ? (unsigned long long)wall_clock64() : 0ull;
#define PG8_STAMP() do { if (STAMP && wid == 0 && nts < 64) { const unsigned long long _c = (unsigned long long)clock64(); \
        ts_lo = (lane == nts) ? (int)(unsigned)_c : ts_lo; ts_hi = (lane == nts) ? (int)(unsigned)(_c >> 32) : ts_hi; ++nts; } } while (0)
    PG8_STAMP();
    unsigned voffA[2], voffB[2];
#pragma unroll
    for (int i = 0; i < 2; ++i) { int R, C; stage_rc(tid * 16 + i * 8192, R, C); const int Rb = Epi::PERM ? ((R & ~31) + perm32(R & 31)) : R;
        voffA[i] = (unsigned)(R * K + C) * 2u; voffB[i] = (unsigned)(Rb * K + C) * 2u; }
    const size_t kstep = (size_t)(BK * 2);
    const size_t hstep = (size_t)HALF * K * 2;
    const size_t tstep = 2 * hstep;
    const unsigned ldsw = (unsigned)wid * 1024u;
    const int aoff = lds_byte(wr * 64 + fr, fq * 8), boff = lds_byte(wc * 32 + fr, fq * 8);
#define PG8_SA(b, h) (((b) * 2 + (h)) * HTB)
#define PG8_SB(b, h) ((4 + (b) * 2 + (h)) * HTB)
#define PG8_STAGE(bufoff, gbase, voff) do { _Pragma("unroll") for (int _i = 0; _i < 2; ++_i) \
        __builtin_amdgcn_global_load_lds((const unsigned*)((const char*)(gbase) + (voff)[_i]), (PG8_LAS unsigned*)(lds + (bufoff) + ldsw + _i * 8192), 16, 0, 0); } while (0)
#define PG8_LDA(dst, b, h) do { _Pragma("unroll") for (int m = 0; m < 4; ++m) _Pragma("unroll") for (int k = 0; k < 2; ++k) dst[m][k] = *(const PG8_LAS bf16x8*)(lds + PG8_SA(b, h) + aoff + m * 2048 + k * 1024); } while (0)
#define PG8_LDB(dst, b, h) do { _Pragma("unroll") for (int n = 0; n < 2; ++n) _Pragma("unroll") for (int k = 0; k < 2; ++k) dst[n][k] = *(const PG8_LAS bf16x8*)(lds + PG8_SB(b, h) + boff + n * 2048 + k * 1024); } while (0)
#define PG8_MMA(ai, bj, At, Bt) do { __builtin_amdgcn_s_setprio(1); _Pragma("unroll") for (int m = 0; m < 4; ++m) _Pragma("unroll") for (int n = 0; n < 2; ++n) _Pragma("unroll") for (int k = 0; k < 2; ++k) \
        acc[ai][bj][m][n] = __builtin_amdgcn_mfma_f32_16x16x32_bf16(Bt[n][k], At[m][k], acc[ai][bj][m][n], 0, 0, 0); __builtin_amdgcn_s_setprio(0); } while (0)
#define PG8_WAIT_V(n) asm volatile("s_waitcnt vmcnt(" #n ")" ::: "memory")
#define PG8_WAIT_L(n) asm volatile("s_waitcnt lgkmcnt(" #n ")" ::: "memory")
#define PG8_BAR __builtin_amdgcn_s_barrier()
#define PG8_SCHED __builtin_amdgcn_sched_barrier(0)
    Unit cur, nxt; int ui = 0;
    if (!S.next(0, cur)) return;
    f32x4 acc[2][2][4][2];
#pragma unroll
    for (int a = 0; a < 2; ++a)
#pragma unroll
        for (int b = 0; b < 2; ++b)
#pragma unroll
            for (int m = 0; m < 4; ++m)
#pragma unroll
                for (int n = 0; n < 2; ++n) acc[a][b][m][n] = (f32x4){0.f, 0.f, 0.f, 0.f};
    bf16x8 At[4][2], B0[2][2], B1[2][2];
    const char* cA = (const char*)g.A + (size_t)cur.pm * tstep; const char* cB = (const char*)g.Bt + (size_t)cur.pn * tstep;
    S.a_ready(cur);
    PG8_STAGE(PG8_SB(0, 0), cB, voffB); PG8_STAGE(PG8_SA(0, 0), cA, voffA); PG8_STAGE(PG8_SB(0, 1), cB + hstep, voffB); PG8_STAGE(PG8_SA(0, 1), cA + hstep, voffA);
    if (wr == 1) PG8_BAR;
    PG8_WAIT_V(4); PG8_BAR;
    PG8_STAGE(PG8_SB(1, 0), cB + kstep, voffB); PG8_STAGE(PG8_SA(1, 0), cA + kstep, voffA); PG8_STAGE(PG8_SB(1, 1), cB + hstep + kstep, voffB);
    PG8_WAIT_V(6); PG8_BAR;
    PG8_STAMP();
    for (;;) {
        const bool has_next = S.next(ui + 1, nxt);
        const char* nA = has_next ? (const char*)g.A + (size_t)nxt.pm * tstep : cA; const char* nB = has_next ? (const char*)g.Bt + (size_t)nxt.pn * tstep : cB;
        for (int t = 0; t < nt; t += 2) {
            const bool last = (t == nt - 2);
            const char* a1 = cA + (size_t)(t + 1) * kstep;
            const char* a2 = last ? nA : cA + (size_t)(t + 2) * kstep; const char* b2 = last ? nB : cB + (size_t)(t + 2) * kstep;
            const char* a3 = a2 + kstep; const char* b3 = b2 + kstep;
            if (last && has_next) S.a_ready(nxt);
            PG8_LDB(B0, 0, 0); PG8_SCHED; PG8_LDA(At, 0, 0); PG8_STAGE(PG8_SA(1, 1), a1 + hstep, voffA);
            PG8_WAIT_L(8); PG8_BAR; PG8_WAIT_L(0); PG8_MMA(0, 0, At, B0); PG8_BAR; PG8_SCHED;
            PG8_LDB(B1, 0, 1); PG8_STAGE(PG8_SB(0, 0), b2, voffB);
            PG8_BAR; PG8_WAIT_L(0); PG8_MMA(0, 1, At, B1); PG8_BAR;
            PG8_LDA(At, 0, 1); PG8_STAGE(PG8_SA(0, 0), a2, voffA);
            PG8_BAR; PG8_WAIT_L(0); PG8_MMA(1, 0, At, B0); PG8_BAR; PG8_SCHED;
            PG8_STAGE(PG8_SB(0, 1), b2 + hstep, voffB);
            PG8_WAIT_V(6); PG8_BAR; PG8_MMA(1, 1, At, B1); PG8_BAR;
            PG8_LDB(B0, 1, 0); PG8_SCHED; PG8_LDA(At, 1, 0); PG8_STAGE(PG8_SA(0, 1), a2 + hstep, voffA);
            PG8_WAIT_L(8); PG8_BAR; PG8_WAIT_L(0); PG8_MMA(0, 0, At, B0); PG8_BAR; PG8_SCHED;
            PG8_LDB(B1, 1, 1); PG8_STAGE(PG8_SB(1, 0), b3, voffB);
            PG8_BAR; PG8_WAIT_L(0); PG8_MMA(0, 1, At, B1); PG8_BAR;
            PG8_LDA(At, 1, 1); PG8_STAGE(PG8_SA(1, 0), a3, voffA);
            PG8_BAR; PG8_WAIT_L(0); PG8_MMA(1, 0, At, B0); PG8_BAR; PG8_SCHED;
            PG8_STAGE(PG8_SB(1, 1), b3 + hstep, voffB);
            PG8_WAIT_V(6); PG8_BAR; PG8_MMA(1, 1, At, B1); PG8_BAR;
        }
        PG8_STAMP();
        if constexpr (!Epi::AFTER_DRAIN) { E(acc, cur, wr, wc, fr, fq); S.done(cur); }
        PG8_STAMP();
        if (!has_next) break;
#pragma unroll
        for (int a = 0; a < 2; ++a)
#pragma unroll
            for (int b = 0; b < 2; ++b)
#pragma unroll
                for (int m = 0; m < 4; ++m)
#pragma unroll
                    for (int n = 0; n < 2; ++n) acc[a][b][m][n] = (f32x4){0.f, 0.f, 0.f, 0.f};
        cur = nxt; cA = nA; cB = nB; ++ui;
    }
    PG8_WAIT_V(0);
    if (wr == 0) PG8_BAR;
    PG8_BAR;
    if constexpr (Epi::AFTER_DRAIN) { E.fused(acc, cur, wr, wc, fr, fq, lds, wid, lane); S.done(cur); }
    PG8_STAMP();
    if (STAMP && wid == 0) { stamps[lane] = lane < nts ? (((unsigned long long)(unsigned)ts_hi << 32) | (unsigned)ts_lo) : 0ull;
        if (lane == 62) stamps[62] = rt_entry; if (lane == 63) stamps[63] = (unsigned long long)wall_clock64(); }
#undef PG8_STAMP
#undef PG8_SA
#undef PG8_SB
#undef PG8_STAGE
#undef PG8_LDA
#undef PG8_LDB
#undef PG8_MMA
#undef PG8_WAIT_V
#undef PG8_WAIT_L
#undef PG8_BAR
#undef PG8_SCHED
}
}

typedef unsigned short bf16_t;
typedef unsigned u32x4 __attribute__((ext_vector_type(4)));
typedef unsigned u32x2 __attribute__((ext_vector_type(2)));
typedef float f32x4 __attribute__((ext_vector_type(4)));
typedef float f32x2 __attribute__((ext_vector_type(2)));
#define LAS __attribute__((address_space(3)))

constexpr int SEQ = 16384, NB = 2, T = NB * SEQ, DM = 2048, DFF = 8192;
constexpr int IN_COLS = 12816, IN_PAD = 13056;
constexpr float EPS = 1e-6f;
constexpr size_t MiB = 1u << 20;
constexpr size_t WS_WT_FF1 = 0, WS_WT_FF2 = 32 * MiB, WS_WT_OUT = 64 * MiB, WS_WT_GDN = 72 * MiB, WS_WT_SWA = 76 * MiB, WS_WT_IN = 78 * MiB,
                 WS_H = 129 * MiB, WS_GRAW = 257 * MiB, WS_Z = 449 * MiB, WS_SQKV = 513 * MiB, WS_OG = 801 * MiB, WS_LSE = 897 * MiB, WS_OB = 78 * MiB,
                 WS_QKVC = 513 * MiB, WS_BETA = 897 * MiB, WS_ALPHA = 898 * MiB, WS_ORAW = 129 * MiB, WS_OA = 899 * MiB, WS_MIXED = 513 * MiB,
                 WS_H2 = 129 * MiB, WS_U = 257 * MiB, WS_AB = 1022 * MiB, WS_END = 1024 * MiB;
constexpr int LDS_BYTES = 144 * 1024;
constexpr int NTHREADS = 512;

static __device__ const double ROPE_REV[64] = {
1.59154943091895346e-01, 1.37822502603982849e-01, 1.19349370211248862e-01, 1.03352296618434064e-01,
8.94994016088910133e-02, 7.75032887553740585e-02, 6.71150830052272551e-02, 5.81192674418762462e-02,
5.03292121044870353e-02, 4.35833021053073297e-02, 3.77415847174197711e-02, 3.26828658723569976e-02,
2.83021958306233987e-02, 2.45086918620698521e-02, 2.12236527647776604e-02, 1.83789261056796667e-02,
1.59154943091895339e-02, 1.37822502603982839e-02, 1.19349370211248862e-02, 1.03352296618434061e-02,
8.94994016088910237e-03, 7.75032887553740550e-03, 6.71150830052272534e-03, 5.81192674418762410e-03,
5.03292121044870370e-03, 4.35833021053073314e-03, 3.77415847174197719e-03, 3.26828658723569932e-03,
2.83021958306233987e-03, 2.45086918620698521e-03, 2.12236527647776622e-03, 1.83789261056796667e-03,
1.59154943091895356e-03, 1.37822502603982878e-03, 1.19349370211248849e-03, 1.03352296618434048e-03,
8.94994016088910237e-04, 7.75032887553740507e-04, 6.71150830052272599e-04, 5.81192674418762388e-04,
5.03292121044870326e-04, 4.35833021053073292e-04, 3.77415847174197741e-04, 3.26828658723569922e-04,
2.83021958306233954e-04, 2.45086918620698543e-04, 2.12236527647776605e-04, 1.83789261056796662e-04,
1.59154943091895351e-04, 1.37822502603982856e-04, 1.19349370211248862e-04, 1.03352296618434061e-04,
8.94994016088910182e-05, 7.75032887553740561e-05, 6.71150830052272545e-05, 5.81192674418762388e-05,
5.03292121044870354e-05, 4.35833021053073225e-05, 3.77415847174197768e-05, 3.26828658723569989e-05,
2.83021958306233961e-05, 2.45086918620698523e-05, 2.12236527647776592e-05, 1.83789261056796682e-05

};

__device__ __forceinline__ unsigned short f2bf(float f) { unsigned u = __float_as_uint(f); u += 0x7FFFu + ((u >> 16) & 1u); return (unsigned short)(u >> 16); }
__device__ __forceinline__ unsigned pack2(float lo, float hi) { return (unsigned)f2bf(lo) | ((unsigned)f2bf(hi) << 16); }
__device__ __forceinline__ float bflo(unsigned w) { return __uint_as_float(w << 16); }
__device__ __forceinline__ float bfhi(unsigned w) { return __uint_as_float(w & 0xffff0000u); }
__device__ __forceinline__ float sigmoidf_(float x) { return 1.0f / (1.0f + __expf(-x)); }
__device__ __forceinline__ float siluf_(float x) { return x / (1.0f + __expf(-x)); }
__device__ __forceinline__ float wave_sum(float v) { v += __shfl_xor(v, 32); v += __shfl_xor(v, 16); v += __shfl_xor(v, 8); v += __shfl_xor(v, 4); v += __shfl_xor(v, 2); v += __shfl_xor(v, 1); return v; }

struct Params { const float* in[16]; float* out; unsigned char* ws; int ph_lo, ph_hi; };

__device__ void wt_tile(const float* __restrict__ src, bf16_t* __restrict__ dst, int K, int N, int kt, int nt, int mode, LAS float* tile) {
    const int tid = threadIdx.x, k0 = kt * 64, n0 = nt * 64;
#pragma unroll
    for (int r = 0; r < 8; ++r) { const int i = (tid >> 6) + 8 * r, j = tid & 63, n = n0 + j; float v = 0.f; if (n < N) v = src[(size_t)(k0 + i) * N + n]; tile[i * 65 + j] = v; }
    __syncthreads();
    { const int j = tid >> 3, ic = tid & 7, n = n0 + j;
      if (n < N) { const int drow = mode ? (n < 4096 ? n : (n < 4112 ? 12800 + (n - 4096) : n - 16)) : n;
          u32x4 w; w.x = pack2(tile[(ic * 8 + 0) * 65 + j], tile[(ic * 8 + 1) * 65 + j]); w.y = pack2(tile[(ic * 8 + 2) * 65 + j], tile[(ic * 8 + 3) * 65 + j]);
          w.z = pack2(tile[(ic * 8 + 4) * 65 + j], tile[(ic * 8 + 5) * 65 + j]); w.w = pack2(tile[(ic * 8 + 6) * 65 + j], tile[(ic * 8 + 7) * 65 + j]);
          *(u32x4*)(dst + (size_t)drow * K + k0 + ic * 8) = w; } }
    __syncthreads();
}
__device__ void rms_rows(const float* __restrict__ src, const float* __restrict__ w, bf16_t* __restrict__ dst) {
    const int lane = threadIdx.x & 63, gw = blockIdx.x * 8 + (threadIdx.x >> 6), nw = gridDim.x * 8;
    for (int row = gw; row < T; row += nw) {
        const f32x4* s = (const f32x4*)(src + (size_t)row * DM); f32x4 v[8]; float ss = 0.f;
#pragma unroll
        for (int i = 0; i < 8; ++i) { v[i] = s[lane + 64 * i]; ss += v[i][0] * v[i][0] + v[i][1] * v[i][1] + v[i][2] * v[i][2] + v[i][3] * v[i][3]; }
        ss = wave_sum(ss); const float r = 1.0f / sqrtf(ss * (1.0f / DM) + EPS);
#pragma unroll
        for (int i = 0; i < 8; ++i) { const f32x4 ww = ((const f32x4*)w)[lane + 64 * i]; u32x2 o; o.x = pack2(v[i][0] * r * ww[0], v[i][1] * r * ww[1]); o.y = pack2(v[i][2] * r * ww[2], v[i][3] * r * ww[3]);
            *(u32x2*)(dst + (size_t)row * DM + (lane + 64 * i) * 4) = o; }
    }
}
__device__ void phase_prep(const Params& p, LAS unsigned char* lds) {
    unsigned char* ws = p.ws; LAS float* tile = (LAS float*)lds;
    const int c0 = 32 * 201, c1 = c0 + 32 * 128, c2 = c1 + 128 * 32, c3 = c2 + 32 * 32, c4 = c3 + 16 * 32, c5 = c4 + 8 * 32;
    for (int t = blockIdx.x; t < c5; t += gridDim.x) {
        if (t < c0) wt_tile(p.in[3], (bf16_t*)(ws + WS_WT_IN), DM, IN_COLS, t / 201, t % 201, 1, tile);
        else if (t < c1) { const int u = t - c0; wt_tile(p.in[14], (bf16_t*)(ws + WS_WT_FF1), DM, DFF, u / 128, u % 128, 0, tile); }
        else if (t < c2) { const int u = t - c1; wt_tile(p.in[15], (bf16_t*)(ws + WS_WT_FF2), DFF, DM, u / 32, u % 32, 0, tile); }
        else if (t < c3) { const int u = t - c2; wt_tile(p.in[12], (bf16_t*)(ws + WS_WT_OUT), DM, DM, u / 32, u % 32, 0, tile); }
        else if (t < c4) { const int u = t - c3; wt_tile(p.in[8], (bf16_t*)(ws + WS_WT_GDN), 1024, DM, u / 32, u % 32, 0, tile); }
        else { const int u = t - c4; wt_tile(p.in[11], (bf16_t*)(ws + WS_WT_SWA), 512, DM, u / 32, u % 32, 0, tile); }
    }
    { u32x4* z = (u32x4*)((bf16_t*)(ws + WS_WT_IN) + (size_t)IN_COLS * DM); const int n16 = (IN_PAD - IN_COLS) * DM / 8;
      for (int i = blockIdx.x * NTHREADS + threadIdx.x; i < n16; i += gridDim.x * NTHREADS) z[i] = (u32x4){0u, 0u, 0u, 0u}; }
    rms_rows(p.in[0], p.in[2], (bf16_t*)(ws + WS_H));
}

struct EpiIn {
    static constexpr bool PERM = true, AFTER_DRAIN = false;
    bf16_t* graw; bf16_t* z; bf16_t* sqkv; bf16_t* gates; float* ab;
    __device__ __forceinline__ void operator()(const f32x4 (&acc)[2][2][4][2], const pg8::Unit& u, int wr, int wc, int fr, int fq) const {
        const int row0 = u.pm * 256 + wr * 64 + fr, pn = u.pn;
        if (pn == 50) {
            if (wc == 0 && fq < 2) {
#pragma unroll
                for (int ai = 0; ai < 2; ++ai)
#pragma unroll
                    for (int m = 0; m < 4; ++m) { float* d = ab + (size_t)(row0 + ai * 128 + m * 16) * 16 + 8 * fq; *(f32x4*)d = acc[ai][0][m][0]; *(f32x4*)(d + 4) = acc[ai][0][m][1]; }
            }
            return;
        }
        bf16_t* base; int ld, colt; bool sig = false;
        if (pn < 12) { base = graw; ld = 3072; colt = pn * 256; }
        else if (pn < 16) { base = z; ld = 1024; colt = (pn - 12) * 256; }
        else if (pn < 34) { base = sqkv; ld = 4608; colt = (pn - 16) * 256; }
        else { base = gates; ld = 4096; colt = (pn - 34) * 256; sig = true; }
        const int col0 = colt + wc * 32 + 8 * fq;
#pragma unroll
        for (int ai = 0; ai < 2; ++ai)
#pragma unroll
            for (int m = 0; m < 4; ++m) { bf16_t* rowp = base + (size_t)(row0 + ai * 128 + m * 16) * ld + col0;
#pragma unroll
                for (int bj = 0; bj < 2; ++bj) { f32x4 v0 = acc[ai][bj][m][0], v1 = acc[ai][bj][m][1];
                    if (sig) {
#pragma unroll
                        for (int j = 0; j < 4; ++j) { v0[j] = sigmoidf_(v0[j]); v1[j] = sigmoidf_(v1[j]); } }
                    u32x4 w; w.x = pack2(v0[0], v0[1]); w.y = pack2(v0[2], v0[3]); w.z = pack2(v1[0], v1[1]); w.w = pack2(v1[2], v1[3]);
                    *(u32x4*)(rowp + bj * 128) = w; } }
    }
};
struct EpiMix {
    static constexpr bool PERM = true, AFTER_DRAIN = false;
    const bf16_t* gates; int goff; bf16_t* mixed; int first;
    __device__ __forceinline__ void operator()(const f32x4 (&acc)[2][2][4][2], const pg8::Unit& u, int wr, int wc, int fr, int fq) const {
        const int row0 = u.pm * 256 + wr * 64 + fr, col0 = u.pn * 256 + wc * 32 + 8 * fq;
#pragma unroll
        for (int ai = 0; ai < 2; ++ai)
#pragma unroll
            for (int m = 0; m < 4; ++m) { const size_t row = (size_t)(row0 + ai * 128 + m * 16);
#pragma unroll
                for (int bj = 0; bj < 2; ++bj) { const int col = col0 + bj * 128;
                    const u32x4 g = *(const u32x4*)(gates + row * 4096 + goff + col);
                    f32x4 v0 = acc[ai][bj][m][0], v1 = acc[ai][bj][m][1];
                    v0[0] *= bflo(g.x); v0[1] *= bfhi(g.x); v0[2] *= bflo(g.y); v0[3] *= bfhi(g.y); v1[0] *= bflo(g.z); v1[1] *= bfhi(g.z); v1[2] *= bflo(g.w); v1[3] *= bfhi(g.w);
                    bf16_t* mp = mixed + row * DM + col;
                    if (!first) { const u32x4 o = *(const u32x4*)mp; v0[0] += bflo(o.x); v0[1] += bfhi(o.x); v0[2] += bflo(o.y); v0[3] += bfhi(o.y); v1[0] += bflo(o.z); v1[1] += bfhi(o.z); v1[2] += bflo(o.w); v1[3] += bfhi(o.w); }
                    u32x4 w; w.x = pack2(v0[0], v0[1]); w.y = pack2(v0[2], v0[3]); w.z = pack2(v1[0], v1[1]); w.w = pack2(v1[2], v1[3]);
                    *(u32x4*)mp = w; } }
    }
};
struct EpiRes {
    static constexpr bool PERM = false, AFTER_DRAIN = false;
    const float* base; float* out;
    __device__ __forceinline__ void operator()(const f32x4 (&acc)[2][2][4][2], const pg8::Unit& u, int wr, int wc, int fr, int fq) const {
        const int row0 = u.pm * 256 + wr * 64 + fr, col0 = u.pn * 256 + wc * 32 + 4 * fq;
#pragma unroll
        for (int ai = 0; ai < 2; ++ai)
#pragma unroll
            for (int m = 0; m < 4; ++m) { const size_t off = (size_t)(row0 + ai * 128 + m * 16) * DM + col0;
#pragma unroll
                for (int bj = 0; bj < 2; ++bj)
#pragma unroll
                    for (int n = 0; n < 2; ++n) { const f32x4 b = *(const f32x4*)(base + off + bj * 128 + n * 16); *(f32x4*)(out + off + bj * 128 + n * 16) = b + acc[ai][bj][m][n]; } }
    }
};
struct EpiRelu2 {
    static constexpr bool PERM = true, AFTER_DRAIN = false;
    bf16_t* U;
    __device__ __forceinline__ void operator()(const f32x4 (&acc)[2][2][4][2], const pg8::Unit& u, int wr, int wc, int fr, int fq) const {
        const int row0 = u.pm * 256 + wr * 64 + fr, col0 = u.pn * 256 + wc * 32 + 8 * fq;
#pragma unroll
        for (int ai = 0; ai < 2; ++ai)
#pragma unroll
            for (int m = 0; m < 4; ++m) { bf16_t* rowp = U + (size_t)(row0 + ai * 128 + m * 16) * DFF + col0;
#pragma unroll
                for (int bj = 0; bj < 2; ++bj) { f32x4 v0 = acc[ai][bj][m][0], v1 = acc[ai][bj][m][1];
#pragma unroll
                    for (int j = 0; j < 4; ++j) { const float a = fmaxf(v0[j], 0.f), b = fmaxf(v1[j], 0.f); v0[j] = a * a; v1[j] = b * b; }
                    u32x4 w; w.x = pack2(v0[0], v0[1]); w.y = pack2(v0[2], v0[3]); w.z = pack2(v1[0], v1[1]); w.w = pack2(v1[2], v1[3]);
                    *(u32x4*)(rowp + bj * 128) = w; } }
    }
};
template <class Epi> __device__ __forceinline__ void run_gemm(LAS unsigned char* lds, const bf16_t* A, const bf16_t* Bt, int M, int N, int K, const Epi& E) {
    pg8::Gemm g{A, Bt, M, N, K}; pg8::StaticOrder S; S.init(M, N, (int)gridDim.x, (int)blockIdx.x);
    pg8::gemm_phase<Epi, pg8::StaticOrder, false>(lds, g, S, E, nullptr);
}

__device__ void phase_swa_prep(const Params& p) {
    bf16_t* sq = (bf16_t*)(p.ws + WS_SQKV); const int* pos = (const int*)p.in[1];
    const int l = threadIdx.x & 31, ghw = blockIdx.x * 16 + (threadIdx.x >> 5), nhw = gridDim.x * 16;
    for (int it = ghw; it < T * 24; it += nhw) {
        const int tok = it / 24, hd = it % 24;
        bf16_t* ptr = sq + (size_t)tok * 4608 + hd * 128 + 2 * l;
        const unsigned lo = *(const unsigned*)ptr, hi = *(const unsigned*)(ptr + 64);
        float x0 = bflo(lo), x1 = bfhi(lo), y0 = bflo(hi), y1 = bfhi(hi);
        float ss = x0 * x0 + x1 * x1 + y0 * y0 + y1 * y1;
        ss += __shfl_xor(ss, 16); ss += __shfl_xor(ss, 8); ss += __shfl_xor(ss, 4); ss += __shfl_xor(ss, 2); ss += __shfl_xor(ss, 1);
        float r = 1.0f / sqrtf(ss * (1.0f / 128.0f) + EPS);
        const float* w = hd < 12 ? p.in[9] : p.in[10];
        if (hd < 12) r *= 0.08838834764831845f;
        x0 *= r * w[2 * l]; x1 *= r * w[2 * l + 1]; y0 *= r * w[64 + 2 * l]; y1 *= r * w[65 + 2 * l];
        const double ps = (double)pos[tok];
        const double a0 = ps * ROPE_REV[2 * l], a1 = ps * ROPE_REV[2 * l + 1];
        const float f0 = (float)(a0 - floor(a0)), f1 = (float)(a1 - floor(a1));
        const float c0 = __builtin_amdgcn_cosf(f0), s0 = __builtin_amdgcn_sinf(f0), c1 = __builtin_amdgcn_cosf(f1), s1 = __builtin_amdgcn_sinf(f1);
        const float ox0 = x0 * c0 - y0 * s0, oy0 = y0 * c0 + x0 * s0, ox1 = x1 * c1 - y1 * s1, oy1 = y1 * c1 + x1 * s1;
        *(unsigned*)ptr = pack2(ox0, ox1); *(unsigned*)(ptr + 64) = pack2(oy0, oy1);
    }
}
constexpr int KROW = 136;
__device__ void phase_swa_attn(const Params& p, LAS unsigned char* lds) {
    const bf16_t* sq = (const bf16_t*)(p.ws + WS_SQKV); bf16_t* og = (bf16_t*)(p.ws + WS_OG); float* lse_out = (float*)(p.ws + WS_LSE);
    LAS bf16_t* Ks = (LAS bf16_t*)lds; LAS bf16_t* Vs = (LAS bf16_t*)(lds + 192 * KROW * 2); LAS float* Sc = (LAS float*)(lds + 2 * 192 * KROW * 2);
    const int tid = threadIdx.x, qi = tid >> 3, sub = tid & 7;
    for (int task = blockIdx.x; task < 6144; task += gridDim.x) {
        const int b = task / 3072; int rem = task % 3072; const int g = rem / 1024; rem %= 1024; const int hh = rem / 256, idx = rem % 256;
        const int dil = 1 << (2 * g), nlb = 256 >> (2 * g), r = idx / nlb, lblk = idx % nlb, l0 = lblk * 64, head = g * 4 + hh;
        __syncthreads();
        for (int ch = tid; ch < 192 * 16; ch += NTHREADS) { const int c = ch >> 4, part = ch & 15, lk = l0 - 128 + c; u32x4 kv = (u32x4){0u, 0u, 0u, 0u}, vv = kv;
            if (lk >= 0) { const bf16_t* rowp = sq + (size_t)(b * SEQ + lk * dil + r) * 4608 + head * 128 + part * 8; kv = *(const u32x4*)(rowp + 1536); vv = *(const u32x4*)(rowp + 3072); }
            *(LAS u32x4*)(Ks + c * KROW + part * 8) = kv; *(LAS u32x4*)(Vs + c * KROW + part * 8) = vv; }
        const int qtok = b * SEQ + (l0 + qi) * dil + r;
        float q[128];
        { const u32x4* qp = (const u32x4*)(sq + (size_t)qtok * 4608 + head * 128);
#pragma unroll
          for (int i = 0; i < 16; ++i) { const u32x4 w = qp[i]; q[8 * i] = bflo(w.x); q[8 * i + 1] = bfhi(w.x); q[8 * i + 2] = bflo(w.y); q[8 * i + 3] = bfhi(w.y); q[8 * i + 4] = bflo(w.z); q[8 * i + 5] = bfhi(w.z); q[8 * i + 6] = bflo(w.w); q[8 * i + 7] = bfhi(w.w); } }
        __syncthreads();
        for (int j = sub; j < 129; j += 8) { const int c = qi + j; float a = 0.f;
#pragma unroll
            for (int i = 0; i < 16; ++i) { const u32x4 w = *(const LAS u32x4*)(Ks + c * KROW + i * 8);
                a += q[8 * i] * bflo(w.x) + q[8 * i + 1] * bfhi(w.x) + q[8 * i + 2] * bflo(w.y) + q[8 * i + 3] * bfhi(w.y) + q[8 * i + 4] * bflo(w.z) + q[8 * i + 5] * bfhi(w.z) + q[8 * i + 6] * bflo(w.w) + q[8 * i + 7] * bfhi(w.w); }
            if (l0 - 128 + c < 0) a = -1e30f;
            Sc[qi * 132 + j] = a; }
        __syncthreads();
        { float m = -3e38f; for (int j = sub; j < 129; j += 8) m = fmaxf(m, Sc[qi * 132 + j]);
          m = fmaxf(m, __shfl_xor(m, 1)); m = fmaxf(m, __shfl_xor(m, 2)); m = fmaxf(m, __shfl_xor(m, 4));
          float s = 0.f; for (int j = sub; j < 129; j += 8) s += __expf(Sc[qi * 132 + j] - m);
          s += __shfl_xor(s, 1); s += __shfl_xor(s, 2); s += __shfl_xor(s, 4);
          const float lse = m + __logf(s);
          for (int j = sub; j < 129; j += 8) Sc[qi * 132 + j] = __expf(Sc[qi * 132 + j] - lse);
          if (sub == 0) lse_out[((size_t)g * T + qtok) * 4 + hh] = lse; }
        __syncthreads();
        { float o[16];
#pragma unroll
          for (int i = 0; i < 16; ++i) o[i] = 0.f;
          for (int j = 0; j < 129; ++j) { const float pj = Sc[qi * 132 + j]; const int c = qi + j;
              const u32x4 w0 = *(const LAS u32x4*)(Vs + c * KROW + sub * 16), w1 = *(const LAS u32x4*)(Vs + c * KROW + sub * 16 + 8);
              o[0] += pj * bflo(w0.x); o[1] += pj * bfhi(w0.x); o[2] += pj * bflo(w0.y); o[3] += pj * bfhi(w0.y); o[4] += pj * bflo(w0.z); o[5] += pj * bfhi(w0.z); o[6] += pj * bflo(w0.w); o[7] += pj * bfhi(w0.w);
              o[8] += pj * bflo(w1.x); o[9] += pj * bfhi(w1.x); o[10] += pj * bflo(w1.y); o[11] += pj * bfhi(w1.y); o[12] += pj * bflo(w1.z); o[13] += pj * bfhi(w1.z); o[14] += pj * bflo(w1.w); o[15] += pj * bfhi(w1.w); }
          bf16_t* op = og + ((size_t)g * T + qtok) * 512 + hh * 128 + sub * 16;
          u32x4 w; w.x = pack2(o[0], o[1]); w.y = pack2(o[2], o[3]); w.z = pack2(o[4], o[5]); w.w = pack2(o[6], o[7]); *(u32x4*)op = w;
          w.x = pack2(o[8], o[9]); w.y = pack2(o[10], o[11]); w.z = pack2(o[12], o[13]); w.w = pack2(o[14], o[15]); *(u32x4*)(op + 8) = w; }
    }
}
__device__ void phase_swa_combine(const Params& p) {
    const bf16_t* og = (const bf16_t*)(p.ws + WS_OG); const float* lse = (const float*)(p.ws + WS_LSE); bf16_t* ob = (bf16_t*)(p.ws + WS_OB);
    for (int it = blockIdx.x * NTHREADS + threadIdx.x; it < T * 64; it += gridDim.x * NTHREADS) {
        const int tok = it >> 6, hh = (it >> 4) & 3, ch = it & 15;
        const float l0 = lse[((size_t)0 * T + tok) * 4 + hh], l1 = lse[((size_t)1 * T + tok) * 4 + hh], l2 = lse[((size_t)2 * T + tok) * 4 + hh];
        const float m = fmaxf(l0, fmaxf(l1, l2)); float w0 = __expf(l0 - m), w1 = __expf(l1 - m), w2 = __expf(l2 - m); const float inv = 1.0f / (w0 + w1 + w2); w0 *= inv; w1 *= inv; w2 *= inv;
        const size_t off = (size_t)tok * 512 + hh * 128 + ch * 8;
        const u32x4 a = *(const u32x4*)(og + off), b = *(const u32x4*)(og + (size_t)T * 512 + off), c = *(const u32x4*)(og + (size_t)2 * T * 512 + off);
        u32x4 o;
        o.x = pack2(w0 * bflo(a.x) + w1 * bflo(b.x) + w2 * bflo(c.x), w0 * bfhi(a.x) + w1 * bfhi(b.x) + w2 * bfhi(c.x));
        o.y = pack2(w0 * bflo(a.y) + w1 * bflo(b.y) + w2 * bflo(c.y), w0 * bfhi(a.y) + w1 * bfhi(b.y) + w2 * bfhi(c.y));
        o.z = pack2(w0 * bflo(a.z) + w1 * bflo(b.z) + w2 * bflo(c.z), w0 * bfhi(a.z) + w1 * bfhi(b.z) + w2 * bfhi(c.z));
        o.w = pack2(w0 * bflo(a.w) + w1 * bflo(b.w) + w2 * bflo(c.w), w0 * bfhi(a.w) + w1 * bfhi(b.w) + w2 * bfhi(c.w));
        *(u32x4*)(ob + off) = o;
    }
}

__device__ void phase_gdn_pre(const Params& p) {
    const bf16_t* graw = (const bf16_t*)(p.ws + WS_GRAW); const float* ab = (const float*)(p.ws + WS_AB); float* qkvc = (float*)(p.ws + WS_QKVC);
    float* beta = (float*)(p.ws + WS_BETA); float* alpha = (float*)(p.ws + WS_ALPHA); const float* cw = p.in[4];
    const int lane = threadIdx.x & 63, gw = blockIdx.x * 8 + (threadIdx.x >> 6), nw = gridDim.x * 8;
    for (int it = gw; it < T * 8; it += nw) {
        const int tok = it >> 3, h = it & 7, t = tok % SEQ;
        float v[3][2];
#pragma unroll
        for (int part = 0; part < 3; ++part) { const int col = part * 1024 + h * 128 + 2 * lane; float y0 = 0.f, y1 = 0.f;
#pragma unroll
            for (int j = 0; j < 4; ++j) { if (t - 3 + j >= 0) { const unsigned x = *(const unsigned*)(graw + (size_t)(tok - 3 + j) * 3072 + col); const f32x2 w = *(const f32x2*)(cw + j * 3072 + col); y0 += w[0] * bflo(x); y1 += w[1] * bfhi(x); } }
            v[part][0] = siluf_(y0); v[part][1] = siluf_(y1); }
        const float sq = wave_sum(v[0][0] * v[0][0] + v[0][1] * v[0][1]), sk = wave_sum(v[1][0] * v[1][0] + v[1][1] * v[1][1]);
        const float rq = 0.08838834764831845f / sqrtf(sq + EPS), rk = 1.0f / sqrtf(sk + EPS);
        float* o = qkvc + (size_t)tok * 3072 + h * 128 + 2 * lane;
        *(f32x2*)o = (f32x2){v[0][0] * rq, v[0][1] * rq}; *(f32x2*)(o + 1024) = (f32x2){v[1][0] * rk, v[1][1] * rk}; *(f32x2*)(o + 2048) = (f32x2){v[2][0], v[2][1]};
        if (lane == 0) { const float a = ab[(size_t)tok * 16 + h], bb = ab[(size_t)tok * 16 + 8 + h]; const float xx = a + p.in[6][h];
            const float sp = xx > 20.f ? xx : log1pf(expf(xx)); const float g = -expf(p.in[5][h]) * sp;
            beta[(size_t)tok * 8 + h] = 1.0f / (1.0f + expf(-bb)); alpha[(size_t)tok * 8 + h] = expf(g); }
    }
}
__device__ void phase_gdn_rec(const Params& p, LAS unsigned char* lds) {
    const float* qkvc = (const float*)(p.ws + WS_QKVC); const float* beta = (const float*)(p.ws + WS_BETA); const float* alpha = (const float*)(p.ws + WS_ALPHA); float* oraw = (float*)(p.ws + WS_ORAW);
    LAS float* qs = (LAS float*)lds; LAS float* ks = qs + 64 * 128; LAS float* vs = ks + 64 * 128; LAS float* bs = vs + 64 * 128; LAS float* as = bs + 64;
    const int tid = threadIdx.x, dq = tid & 3, e = tid >> 2;
    for (int bh = blockIdx.x; bh < 16; bh += gridDim.x) {
        const int b = bh >> 3, h = bh & 7;
        float S[32];
#pragma unroll
        for (int i = 0; i < 32; ++i) S[i] = 0.f;
        for (int t0 = 0; t0 < SEQ; t0 += 64) {
            __syncthreads();
            for (int idx = tid; idx < 64 * 32; idx += NTHREADS) { const int tt = idx >> 5, c4 = idx & 31; const float* src = qkvc + (size_t)(b * SEQ + t0 + tt) * 3072 + h * 128 + c4 * 4;
                *(LAS f32x4*)(qs + tt * 128 + c4 * 4) = *(const f32x4*)src; *(LAS f32x4*)(ks + tt * 128 + c4 * 4) = *(const f32x4*)(src + 1024); *(LAS f32x4*)(vs + tt * 128 + c4 * 4) = *(const f32x4*)(src + 2048); }
            if (tid < 64) { bs[tid] = beta[(size_t)(b * SEQ + t0 + tid) * 8 + h]; as[tid] = alpha[(size_t)(b * SEQ + t0 + tid) * 8 + h]; }
            __syncthreads();
            for (int tt = 0; tt < 64; ++tt) {
                float kk[32]; float kS = 0.f;
#pragma unroll
                for (int i = 0; i < 8; ++i) { const f32x4 w = *(const LAS f32x4*)(ks + tt * 128 + dq * 32 + i * 4); kk[4 * i] = w[0]; kk[4 * i + 1] = w[1]; kk[4 * i + 2] = w[2]; kk[4 * i + 3] = w[3]; }
#pragma unroll
                for (int i = 0; i < 32; ++i) kS += kk[i] * S[i];
                kS += __shfl_xor(kS, 1); kS += __shfl_xor(kS, 2);
                const float al = as[tt], be = bs[tt], vv = vs[tt * 128 + e];
                const float c = be * (vv - al * kS);
                float o = 0.f;
#pragma unroll
                for (int i = 0; i < 8; ++i) { const f32x4 w = *(const LAS f32x4*)(qs + tt * 128 + dq * 32 + i * 4);
#pragma unroll
                    for (int j = 0; j < 4; ++j) { S[4 * i + j] = al * S[4 * i + j] + c * kk[4 * i + j]; o += w[j] * S[4 * i + j]; } }
                o += __shfl_xor(o, 1); o += __shfl_xor(o, 2);
                if (dq == 0) oraw[(size_t)(b * SEQ + t0 + tt) * 1024 + h * 128 + e] = o;
            }
        }
    }
}
__device__ void phase_gdn_norm(const Params& p) {
    const float* oraw = (const float*)(p.ws + WS_ORAW); const bf16_t* z = (const bf16_t*)(p.ws + WS_Z); bf16_t* oa = (bf16_t*)(p.ws + WS_OA); const float* nw = p.in[7];
    const int lane = threadIdx.x & 63, gw = blockIdx.x * 8 + (threadIdx.x >> 6), nwv = gridDim.x * 8;
    for (int it = gw; it < T * 8; it += nwv) {
        const size_t off = (size_t)it * 128 + 2 * lane;
        const f32x2 o = *(const f32x2*)(oraw + off); const float ss = wave_sum(o[0] * o[0] + o[1] * o[1]); const float r = 1.0f / sqrtf(ss * (1.0f / 128.0f) + EPS);
        const unsigned zz = *(const unsigned*)(z + off);
        *(unsigned*)(oa + off) = pack2(o[0] * r * nw[2 * lane] * siluf_(bflo(zz)), o[1] * r * nw[2 * lane + 1] * siluf_(bfhi(zz)));
    }
}

constexpr int NPHASE = 13;
__global__ void __launch_bounds__(NTHREADS, 2) mega(Params p) {
    extern __shared__ __attribute__((aligned(16))) unsigned char lds_raw[];
    LAS unsigned char* lds = (LAS unsigned char*)lds_raw;
    cg::grid_group grid = cg::this_grid();
    unsigned char* ws = p.ws;
    const int lo = p.ph_lo, hi = p.ph_hi;
#define IN(k) (lo <= (k) && (k) < hi)
#define SEAM(k) do { if (IN(k) && IN((k) + 1)) grid.sync(); } while (0)
    if (IN(0)) { phase_prep(p, lds); } SEAM(0);
    if (IN(1)) { EpiIn E{(bf16_t*)(ws + WS_GRAW), (bf16_t*)(ws + WS_Z), (bf16_t*)(ws + WS_SQKV), (bf16_t*)p.out, (float*)(ws + WS_AB)};
        run_gemm(lds, (const bf16_t*)(ws + WS_H), (const bf16_t*)(ws + WS_WT_IN), T, IN_PAD, DM, E); } SEAM(1);
    if (IN(2)) { phase_swa_prep(p); } SEAM(2);
    if (IN(3)) { phase_swa_attn(p, lds); } SEAM(3);
    if (IN(4)) { phase_swa_combine(p); } SEAM(4);
    if (IN(5)) { phase_gdn_pre(p); } SEAM(5);
    if (IN(6)) { phase_gdn_rec(p, lds); } SEAM(6);
    if (IN(7)) { phase_gdn_norm(p); } SEAM(7);
    if (IN(8)) { { EpiMix E{(const bf16_t*)p.out, 0, (bf16_t*)(ws + WS_MIXED), 1}; run_gemm(lds, (const bf16_t*)(ws + WS_OA), (const bf16_t*)(ws + WS_WT_GDN), T, DM, 1024, E); }
                 { EpiMix E{(const bf16_t*)p.out, 2048, (bf16_t*)(ws + WS_MIXED), 0}; run_gemm(lds, (const bf16_t*)(ws + WS_OB), (const bf16_t*)(ws + WS_WT_SWA), T, DM, 512, E); } } SEAM(8);
    if (IN(9)) { EpiRes E{p.in[0], p.out}; run_gemm(lds, (const bf16_t*)(ws + WS_MIXED), (const bf16_t*)(ws + WS_WT_OUT), T, DM, DM, E); } SEAM(9);
    if (IN(10)) { rms_rows(p.out, p.in[13], (bf16_t*)(ws + WS_H2)); } SEAM(10);
    if (IN(11)) { EpiRelu2 E{(bf16_t*)(ws + WS_U)}; run_gemm(lds, (const bf16_t*)(ws + WS_H2), (const bf16_t*)(ws + WS_WT_FF1), T, DFF, DM, E); } SEAM(11);
    if (IN(12)) { EpiRes E{p.out, p.out}; run_gemm(lds, (const bf16_t*)(ws + WS_U), (const bf16_t*)(ws + WS_WT_FF2), T, DM, DFF, E); }
#undef IN
#undef SEAM
}

#ifndef ONE_LAUNCH
#define ONE_LAUNCH 0
#endif
extern "C" void kernel_launch(void* const* d_in, const int* in_sizes, int n_in, void* d_out, int out_size, void* d_ws, size_t ws_size, hipStream_t stream) {
    if (n_in != 16 || ws_size < WS_END || out_size != T * DM) { fprintf(stderr, "kernel_launch: unexpected shapes (n_in %d ws %zu out %d)\n", n_in, ws_size, out_size); return; }
    static int grid = 0;
    if (grid == 0) { int dev = 0, cus = 0; (void)hipGetDevice(&dev); (void)hipDeviceGetAttribute(&cus, hipDeviceAttributeMultiprocessorCount, dev); grid = cus > 0 ? cus : 256; }
    (void)hipFuncSetAttribute((const void*)mega, hipFuncAttributeMaxDynamicSharedMemorySize, LDS_BYTES);
    Params p{};
    for (int i = 0; i < 16; ++i) p.in[i] = (const float*)d_in[i];
    p.out = (float*)d_out; p.ws = (unsigned char*)d_ws;
#if ONE_LAUNCH
    p.ph_lo = 0; p.ph_hi = NPHASE;
    void* args[] = {&p};
    hipError_t e = hipLaunchCooperativeKernel((const void*)mega, dim3(grid), dim3(NTHREADS), args, LDS_BYTES, stream);
    if (e != hipSuccess) fprintf(stderr, "cooperative launch failed: %s (grid %d)\n", hipGetErrorString(e), grid);
#else
    for (int ph = 0; ph < NPHASE; ++ph) { p.ph_lo = ph; p.ph_hi = ph + 1; hipLaunchKernelGGL(mega, dim3(grid), dim3(NTHREADS), LDS_BYTES, stream, p); }
#endif
}
```

```cpp
#include <hip/hip_runtime.h>
#include <hip/hip_cooperative_groups.h>
#include <cstdio>
namespace cg = cooperative_groups;
namespace pg8 {
#define PG8_LAS __attribute__((address_space(3)))
typedef unsigned short bf16_t;
typedef short bf16x8 __attribute__((ext_vector_type(8)));
typedef float f32x4 __attribute__((ext_vector_type(4)));
typedef unsigned u32x4 __attribute__((ext_vector_type(4)));
constexpr int BM = 256, BK = 64, HALF = 128, HTB = HALF * BK * 2  , STAGE_BYTES = 8 * HTB, NXCD = 8, WGM = 8;

__host__ __device__ __forceinline__ int lds_byte(int r, int c) { const int st = (r >> 4) * 2 + (c >> 5), rr = r & 15, cc = c & 31, ob = rr * 64 + cc * 2; return st * 1024 + (ob ^ (((ob >> 9) & 1) << 5)); }
__host__ __device__ __forceinline__ void stage_rc(int b, int& R, int& C) { const int st = b / 1024, sb = b % 1024, swz = sb ^ (((sb >> 9) & 1) << 5); R = (st >> 1) * 16 + swz / 64; C = (st & 1) * 32 + (swz % 64) / 2; }
__host__ __device__ __forceinline__ int perm32(int rho) { const int n = rho >> 4, i = rho & 15; return 8 * (i >> 2) + 4 * n + (i & 3); }

struct Unit { int pm, pn; };
struct Gemm { const bf16_t* A; const bf16_t* Bt; int M, N, K; };

struct StaticOrder {
    int nM, nN, nwg, G, c;
    __host__ __device__ void init(int M, int N, int G_, int c_) { nM = M / BM; nN = N / BM; nwg = nM * nN; G = G_; c = c_; }
    __host__ __device__ bool next(int i, Unit& u) const {
        const long L = (long)i * G + c; if (L >= nwg) return false;
        int wgid = (int)L; { const int q = nwg / NXCD, r = nwg % NXCD, xcd = wgid % NXCD, off = wgid / NXCD; wgid = (xcd < r ? xcd * (q + 1) : r * (q + 1) + (xcd - r) * q) + off; }
        const int nig = WGM * nN, gid = wgid / nig, fm = gid * WGM, gsz = (nM - fm) < WGM ? (nM - fm) : WGM;
        u.pm = fm + ((wgid % nig) % gsz); u.pn = (wgid % nig) / gsz; return true;
    }
    __device__ __forceinline__ void a_ready(const Unit&) const {}
    __device__ __forceinline__ void done(const Unit&) const {}
};
__device__ __forceinline__ unsigned cvt_pk_bf16(float lo, float hi) { unsigned r; asm volatile("v_cvt_pk_bf16_f32 %0, %1, %2" : "=v"(r) : "v"(lo), "v"(hi)); return r; }
typedef float f32x2 __attribute__((ext_vector_type(2)));
typedef int i32x8 __attribute__((ext_vector_type(8)));
typedef int i32x4v __attribute__((ext_vector_type(4)));
__device__ __forceinline__ void mfma_f8_acc(f32x4& c, const i32x8& b, const i32x8& a) { asm volatile("v_mfma_f32_16x16x128_f8f6f4 %0, %1, %2, %0" : "+v"(c) : "v"(b), "v"(a)); }
template <class Epi, class Sched, bool STAMP = false, bool F8 = false>
__device__ __forceinline__ void gemm_phase(PG8_LAS unsigned char* lds, const Gemm g, const Sched& S, const Epi& E, unsigned long long* stamps) {
    const int tid = threadIdx.x, wid = __builtin_amdgcn_readfirstlane(tid >> 6), lane = tid & 63, wr = wid >> 2, wc = wid & 3, fr = lane & 15, fq = lane >> 4;
    const int K = g.K, nt = K / BK;
    int ts_lo = 0, ts_hi = 0, nts = 0; const unsigned long long rt_entry = STAMP ? (unsigned long long)wall_clock64() : 0ull;
#define PG8_STAMP() do { if (STAMP && wid == 0 && nts < 64) { const unsigned long long _c = (unsigned long long)clock64(); \
        ts_lo = (lane == nts) ? (int)(unsigned)_c : ts_lo; ts_hi = (lane == nts) ? (int)(unsigned)(_c >> 32) : ts_hi; ++nts; } } while (0)
    PG8_STAMP();
    unsigned voffA[2], voffB[2];
#pragma unroll
    for (int i = 0; i < 2; ++i) { int R, C; stage_rc(tid * 16 + i * 8192, R, C); const int Rb = Epi::PERM ? ((R & ~31) + perm32(R & 31)) : R;
        voffA[i] = (unsigned)(R * K + C) * 2u; voffB[i] = (unsigned)(Rb * K + C) * 2u; }
    const size_t kstep = (size_t)(BK * 2);
    const size_t hstep = (size_t)HALF * K * 2;
    const size_t tstep = 2 * hstep;
    const unsigned ldsw = (unsigned)wid * 1024u;
    const int aoff = lds_byte(wr * 64 + fr, fq * 8), boff = lds_byte(wc * 32 + fr, fq * 8);
#define PG8_SA(b, h) (((b) * 2 + (h)) * HTB)
#define PG8_SB(b, h) ((4 + (b) * 2 + (h)) * HTB)
#define PG8_STAGE(bufoff, gbase, voff) do { _Pragma("unroll") for (int _i = 0; _i < 2; ++_i) \
        __builtin_amdgcn_global_load_lds((const unsigned*)((const char*)(gbase) + (voff)[_i]), (PG8_LAS unsigned*)(lds + (bufoff) + ldsw + _i * 8192), 16, 0, 0); } while (0)
#define PG8_LDA(dst, b, h) do { if constexpr (F8) { _Pragma("unroll") for (int m = 0; m < 4; ++m) { const i32x4v lo_ = *(const PG8_LAS i32x4v*)(lds + PG8_SA(b, h) + aoff + m * 2048), hi_ = *(const PG8_LAS i32x4v*)(lds + PG8_SA(b, h) + aoff + m * 2048 + 1024); dst##8[m] = __builtin_shufflevector(lo_, hi_, 0, 1, 2, 3, 4, 5, 6, 7); } } \
        else { _Pragma("unroll") for (int m = 0; m < 4; ++m) _Pragma("unroll") for (int k = 0; k < 2; ++k) dst[m][k] = *(const PG8_LAS bf16x8*)(lds + PG8_SA(b, h) + aoff + m * 2048 + k * 1024); } } while (0)
#define PG8_LDB(dst, b, h) do { if constexpr (F8) { _Pragma("unroll") for (int n = 0; n < 2; ++n) { const i32x4v lo_ = *(const PG8_LAS i32x4v*)(lds + PG8_SB(b, h) + boff + n * 2048), hi_ = *(const PG8_LAS i32x4v*)(lds + PG8_SB(b, h) + boff + n * 2048 + 1024); dst##8[n] = __builtin_shufflevector(lo_, hi_, 0, 1, 2, 3, 4, 5, 6, 7); } } \
        else { _Pragma("unroll") for (int n = 0; n < 2; ++n) _Pragma("unroll") for (int k = 0; k < 2; ++k) dst[n][k] = *(const PG8_LAS bf16x8*)(lds + PG8_SB(b, h) + boff + n * 2048 + k * 1024); } } while (0)
#define PG8_MMA(ai, bj, At, Bt) do { __builtin_amdgcn_s_setprio(1); _Pragma("unroll") for (int m = 0; m < 4; ++m) _Pragma("unroll") for (int n = 0; n < 2; ++n) { \
        if constexpr (F8) mfma_f8_acc(acc[ai][bj][m][n], Bt##8[n], At##8[m]); \
        else { _Pragma("unroll") for (int k = 0; k < 2; ++k) acc[ai][bj][m][n] = __builtin_amdgcn_mfma_f32_16x16x32_bf16(Bt[n][k], At[m][k], acc[ai][bj][m][n], 0, 0, 0); } } __builtin_amdgcn_s_setprio(0); } while (0)
#define PG8_WAIT_V(n) asm volatile("s_waitcnt vmcnt(" #n ")" ::: "memory")
#define PG8_WAIT_L(n) asm volatile("s_waitcnt lgkmcnt(" #n ")" ::: "memory")
#define PG8_BAR __builtin_amdgcn_s_barrier()
#define PG8_SCHED __builtin_amdgcn_sched_barrier(0)
    Unit cur, nxt; int ui = 0;
    if (!S.next(0, cur)) return;
    f32x4 acc[2][2][4][2];
#pragma unroll
    for (int a = 0; a < 2; ++a)
#pragma unroll
        for (int b = 0; b < 2; ++b)
#pragma unroll
            for (int m = 0; m < 4; ++m)
#pragma unroll
                for (int n = 0; n < 2; ++n) acc[a][b][m][n] = (f32x4){0.f, 0.f, 0.f, 0.f};
    bf16x8 At[4][2], B0[2][2], B1[2][2]; i32x8 At8[4], B08[2], B18[2];
    const char* cA = (const char*)g.A + (size_t)cur.pm * tstep; const char* cB = (const char*)g.Bt + (size_t)cur.pn * tstep;
    S.a_ready(cur);
    PG8_STAGE(PG8_SB(0, 0), cB, voffB); PG8_STAGE(PG8_SA(0, 0), cA, voffA); PG8_STAGE(PG8_SB(0, 1), cB + hstep, voffB); PG8_STAGE(PG8_SA(0, 1), cA + hstep, voffA);
    if (wr == 1) PG8_BAR;
    PG8_WAIT_V(4); PG8_BAR;
    PG8_STAGE(PG8_SB(1, 0), cB + kstep, voffB); PG8_STAGE(PG8_SA(1, 0), cA + kstep, voffA); PG8_STAGE(PG8_SB(1, 1), cB + hstep + kstep, voffB);
    PG8_WAIT_V(6); PG8_BAR;
    PG8_STAMP();
    for (;;) {
        const bool has_next = S.next(ui + 1, nxt);
        const char* nA = has_next ? (const char*)g.A + (size_t)nxt.pm * tstep : cA; const char* nB = has_next ? (const char*)g.Bt + (size_t)nxt.pn * tstep : cB;
        for (int t = 0; t < nt; t += 2) {
            const bool last = (t == nt - 2);
            const char* a1 = cA + (size_t)(t + 1) * kstep;
            const char* a2 = last ? nA : cA + (size_t)(t + 2) * kstep; const char* b2 = last ? nB : cB + (size_t)(t + 2) * kstep;
            const char* a3 = a2 + kstep; const char* b3 = b2 + kstep;
            if (last && has_next) S.a_ready(nxt);
            PG8_LDB(B0, 0, 0); PG8_SCHED; PG8_LDA(At, 0, 0); PG8_STAGE(PG8_SA(1, 1), a1 + hstep, voffA);
            PG8_WAIT_L(8); PG8_BAR; PG8_WAIT_L(0); PG8_MMA(0, 0, At, B0); PG8_BAR; PG8_SCHED;
            PG8_LDB(B1, 0, 1); PG8_STAGE(PG8_SB(0, 0), b2, voffB);
            PG8_BAR; PG8_WAIT_L(0); PG8_MMA(0, 1, At, B1); PG8_BAR;
            PG8_LDA(At, 0, 1); PG8_STAGE(PG8_SA(0, 0), a2, voffA);
            PG8_BAR; PG8_WAIT_L(0); PG8_MMA(1, 0, At, B0); PG8_BAR; PG8_SCHED;
            PG8_STAGE(PG8_SB(0, 1), b2 + hstep, voffB);
            PG8_WAIT_V(6); PG8_BAR; PG8_MMA(1, 1, At, B1); PG8_BAR;
            PG8_LDB(B0, 1, 0); PG8_SCHED; PG8_LDA(At, 1, 0); PG8_STAGE(PG8_SA(0, 1), a2 + hstep, voffA);
            PG8_WAIT_L(8); PG8_BAR; PG8_WAIT_L(0); PG8_MMA(0, 0, At, B0); PG8_BAR; PG8_SCHED;
            PG8_LDB(B1, 1, 1); PG8_STAGE(PG8_SB(1, 0), b3, voffB);
            PG8_BAR; PG8_WAIT_L(0); PG8_MMA(0, 1, At, B1); PG8_BAR;
            PG8_LDA(At, 1, 1); PG8_STAGE(PG8_SA(1, 0), a3, voffA);
            PG8_BAR; PG8_WAIT_L(0); PG8_MMA(1, 0, At, B0); PG8_BAR; PG8_SCHED;
            PG8_STAGE(PG8_SB(1, 1), b3 + hstep, voffB);
            PG8_WAIT_V(6); PG8_BAR; PG8_MMA(1, 1, At, B1); PG8_BAR;
        }
        PG8_STAMP();
        if constexpr (F8) {
            asm volatile("s_nop 15\n\ts_nop 15" : "+v"(acc[0][0][0][0]), "+v"(acc[0][0][0][1]), "+v"(acc[0][0][1][0]), "+v"(acc[0][0][1][1]), "+v"(acc[0][0][2][0]), "+v"(acc[0][0][2][1]), "+v"(acc[0][0][3][0]), "+v"(acc[0][0][3][1]), "+v"(acc[0][1][0][0]), "+v"(acc[0][1][0][1]), "+v"(acc[0][1][1][0]), "+v"(acc[0][1][1][1]), "+v"(acc[0][1][2][0]), "+v"(acc[0][1][2][1]), "+v"(acc[0][1][3][0]), "+v"(acc[0][1][3][1]));
            asm volatile("s_nop 15\n\ts_nop 15" : "+v"(acc[1][0][0][0]), "+v"(acc[1][0][0][1]), "+v"(acc[1][0][1][0]), "+v"(acc[1][0][1][1]), "+v"(acc[1][0][2][0]), "+v"(acc[1][0][2][1]), "+v"(acc[1][0][3][0]), "+v"(acc[1][0][3][1]), "+v"(acc[1][1][0][0]), "+v"(acc[1][1][0][1]), "+v"(acc[1][1][1][0]), "+v"(acc[1][1][1][1]), "+v"(acc[1][1][2][0]), "+v"(acc[1][1][2][1]), "+v"(acc[1][1][3][0]), "+v"(acc[1][1][3][1])); }
        if constexpr (!Epi::AFTER_DRAIN) { E(acc, cur, wr, wc, fr, fq); S.done(cur); }
        PG8_STAMP();
        if (!has_next) break;
#pragma unroll
        for (int a = 0; a < 2; ++a)
#pragma unroll
            for (int b = 0; b < 2; ++b)
#pragma unroll
                for (int m = 0; m < 4; ++m)
#pragma unroll
                    for (int n = 0; n < 2; ++n) acc[a][b][m][n] = (f32x4){0.f, 0.f, 0.f, 0.f};
        cur = nxt; cA = nA; cB = nB; ++ui;
    }
    PG8_WAIT_V(0);
    if (wr == 0) PG8_BAR;
    PG8_BAR;
    if constexpr (Epi::AFTER_DRAIN) { E.fused(acc, cur, wr, wc, fr, fq, lds, wid, lane); S.done(cur); }
    PG8_STAMP();
    if (STAMP && wid == 0) { stamps[lane] = lane < nts ? (((unsigned long long)(unsigned)ts_hi << 32) | (unsigned)ts_lo) : 0ull;
        if (lane == 62) stamps[62] = rt_entry; if (lane == 63) stamps[63] = (unsigned long long)wall_clock64(); }
#undef PG8_STAMP
#undef PG8_SA
#undef PG8_SB
#undef PG8_STAGE
#undef PG8_LDA
#undef PG8_LDB
#undef PG8_MMA
#undef PG8_WAIT_V
#undef PG8_WAIT_L
#undef PG8_BAR
#undef PG8_SCHED
}
}

typedef unsigned short bf16_t;
typedef unsigned u32x4 __attribute__((ext_vector_type(4)));
typedef unsigned u32x2 __attribute__((ext_vector_type(2)));
typedef float f32x4 __attribute__((ext_vector_type(4)));
typedef float f32x2 __attribute__((ext_vector_type(2)));
#define LAS __attribute__((address_space(3)))

constexpr int SEQ = 16384, NB = 2, T = NB * SEQ, DM = 2048, DFF = 8192;
constexpr int IN_COLS = 12816, IN_PAD = 13056;
constexpr float EPS = 1e-6f;
constexpr size_t MiB = 1u << 20;
constexpr size_t WS_WT_FF1 = 0, WS_WT_FF2 = 32 * MiB, WS_WT_OUT = 64 * MiB, WS_WT_GDN = 72 * MiB, WS_WT_SWA = 76 * MiB, WS_WT_IN = 78 * MiB,
                 WS_H = 129 * MiB, WS_WF = 257 * MiB, WS_QF = 321 * MiB, WS_KF = 385 * MiB, WS_AF = 449 * MiB, WS_UACC = 481 * MiB,
                 WS_GRAW = 545 * MiB, WS_Z = 545 * MiB, WS_ORAW = 609 * MiB, WS_SQKV = 673 * MiB, WS_GDEC = 961 * MiB, WS_CTR = 962 * MiB, WS_ROWSS = 963 * MiB, WS_ROPE = 964 * MiB,
                 WS_OG = 129 * MiB, WS_LSE = 225 * MiB, WS_OA = 257 * MiB, WS_OB = 321 * MiB, WS_MIXED = 385 * MiB,
                 WS_X1B = 129 * MiB, WS_U = 257 * MiB, WS_AB = 1022 * MiB, WS_END = 1024 * MiB;
constexpr size_t OUT_G8 = 0, OUT_H8 = 128 * MiB;
constexpr size_t WS_WG8 = WS_WT_IN + (size_t)4352 * 2048 * 2;
constexpr int IN_A_ROWS = 3328;
constexpr int LDS_BYTES = 144 * 1024;
constexpr int NTHREADS = 512;

static __device__ const double ROPE_REV[64] = {
1.59154943091895346e-01, 1.37822502603982849e-01, 1.19349370211248862e-01, 1.03352296618434064e-01,
8.94994016088910133e-02, 7.75032887553740585e-02, 6.71150830052272551e-02, 5.81192674418762462e-02,
5.03292121044870353e-02, 4.35833021053073297e-02, 3.77415847174197711e-02, 3.26828658723569976e-02,
2.83021958306233987e-02, 2.45086918620698521e-02, 2.12236527647776604e-02, 1.83789261056796667e-02,
1.59154943091895339e-02, 1.37822502603982839e-02, 1.19349370211248862e-02, 1.03352296618434061e-02,
8.94994016088910237e-03, 7.75032887553740550e-03, 6.71150830052272534e-03, 5.81192674418762410e-03,
5.03292121044870370e-03, 4.35833021053073314e-03, 3.77415847174197719e-03, 3.26828658723569932e-03,
2.83021958306233987e-03, 2.45086918620698521e-03, 2.12236527647776622e-03, 1.83789261056796667e-03,
1.59154943091895356e-03, 1.37822502603982878e-03, 1.19349370211248849e-03, 1.03352296618434048e-03,
8.94994016088910237e-04, 7.75032887553740507e-04, 6.71150830052272599e-04, 5.81192674418762388e-04,
5.03292121044870326e-04, 4.35833021053073292e-04, 3.77415847174197741e-04, 3.26828658723569922e-04,
2.83021958306233954e-04, 2.45086918620698543e-04, 2.12236527647776605e-04, 1.83789261056796662e-04,
1.59154943091895351e-04, 1.37822502603982856e-04, 1.19349370211248862e-04, 1.03352296618434061e-04,
8.94994016088910182e-05, 7.75032887553740561e-05, 6.71150830052272545e-05, 5.81192674418762388e-05,
5.03292121044870354e-05, 4.35833021053073225e-05, 3.77415847174197768e-05, 3.26828658723569989e-05,
2.83021958306233961e-05, 2.45086918620698523e-05, 2.12236527647776592e-05, 1.83789261056796682e-05

};

typedef __bf16 hwbf16x2 __attribute__((ext_vector_type(2)));
__device__ __forceinline__ unsigned pack2(float lo, float hi) { const f32x2 v = {lo, hi}; return __builtin_bit_cast(unsigned, __builtin_convertvector(v, hwbf16x2)); }
__device__ __forceinline__ unsigned short f2bf(float f) { return (unsigned short)(pack2(f, 0.f) & 0xffffu); }
__device__ __forceinline__ float bflo(unsigned w) { return __uint_as_float(w << 16); }
__device__ __forceinline__ float bfhi(unsigned w) { return __uint_as_float(w & 0xffff0000u); }
__device__ __forceinline__ float sigmoidf_(float x) { return __builtin_amdgcn_rcpf(1.0f + __expf(-x)); }
__device__ __forceinline__ float siluf_(float x) { return x * __builtin_amdgcn_rcpf(1.0f + __expf(-x)); }
template <int CTRL> __device__ __forceinline__ float dpp_f(float v) { return __builtin_bit_cast(float, __builtin_amdgcn_update_dpp(0, __builtin_bit_cast(int, v), CTRL, 0xF, 0xF, false)); }
__device__ __forceinline__ float wave_sum(float v) {
    v += dpp_f<0xB1>(v); v += dpp_f<0x4E>(v); v += dpp_f<0x124>(v); v += dpp_f<0x128>(v);
    const int iv = __builtin_bit_cast(int, v);
    const float r0 = __builtin_bit_cast(float, __builtin_amdgcn_readlane(iv, 0)), r1 = __builtin_bit_cast(float, __builtin_amdgcn_readlane(iv, 16)), r2 = __builtin_bit_cast(float, __builtin_amdgcn_readlane(iv, 32)), r3 = __builtin_bit_cast(float, __builtin_amdgcn_readlane(iv, 48));
    return (r0 + r1) + (r2 + r3);
}

__device__ __forceinline__ void lds_barrier() { asm volatile("s_waitcnt lgkmcnt(0)" ::: "memory"); __builtin_amdgcn_s_barrier(); asm volatile("" ::: "memory"); }
typedef short bf16x8 __attribute__((ext_vector_type(8)));
__device__ __forceinline__ f32x4 mfma16(u32x4 a, u32x4 b, f32x4 c) { return __builtin_amdgcn_mfma_f32_16x16x32_bf16(__builtin_bit_cast(bf16x8, a), __builtin_bit_cast(bf16x8, b), c, 0, 0, 0); }
struct Params { const float* in[16]; float* out; unsigned char* ws; int ph_lo, ph_hi; };

struct WtTask { const float* src; const float* scale; bf16_t* dst; int K, N, kt, nt, mode; };
__device__ __forceinline__ WtTask wt_task(const Params& p, int t) {
    unsigned char* ws = p.ws;
    const int c0 = 16 * 201, c1 = c0 + 16 * 128, c2 = c1 + 64 * 32, c3 = c2 + 16 * 32, c4 = c3 + 8 * 32;
    if (t < c0) return WtTask{p.in[3], nullptr, (bf16_t*)(ws + WS_WT_IN), DM, IN_COLS, t / 201, t % 201, 1};
    if (t < c1) { const int u = t - c0; return WtTask{p.in[14], p.in[13], (bf16_t*)(ws + WS_WT_FF1), DM, DFF, u / 128, u % 128, 0}; }
    if (t < c2) { const int u = t - c1; return WtTask{p.in[15], nullptr, (bf16_t*)(ws + WS_WT_FF2), DFF, DM, u / 32, u % 32, 0}; }
    if (t < c3) { const int u = t - c2; return WtTask{p.in[12], nullptr, (bf16_t*)(ws + WS_WT_OUT), DM, DM, u / 32, u % 32, 0}; }
    if (t < c4) { const int u = t - c3; return WtTask{p.in[8], nullptr, (bf16_t*)(ws + WS_WT_GDN), 1024, DM, u / 32, u % 32, 0}; }
    const int u = t - c4; return WtTask{p.in[11], nullptr, (bf16_t*)(ws + WS_WT_SWA), 512, DM, u / 32, u % 32, 0};
}
__device__ __forceinline__ void wt_load(const WtTask& k, float (&v)[16]) {
    const int tid = threadIdx.x, k0 = k.kt * 128, n = k.nt * 64 + (tid & 63);
#pragma unroll
    for (int r = 0; r < 16; ++r) { const int i = (tid >> 6) + 8 * r; float x = 0.f; if (n < k.N) x = k.src[(size_t)(k0 + i) * k.N + n]; if (k.scale) x *= k.scale[k0 + i]; v[r] = x; }
}
__device__ __forceinline__ void wt_all(const Params& p, LAS float* lds_tiles) {
    const int ntask = 16 * 201 + 16 * 128 + 64 * 32 + 16 * 32 + 8 * 32 + 4 * 32;
    const int tid = threadIdx.x; int t = blockIdx.x, it = 0; if (t >= ntask) return;
    WtTask cur = wt_task(p, t); float v[16]; wt_load(cur, v);
    for (;;) {
        LAS float* tile = lds_tiles + (it & 1) * (128 * 65);
#pragma unroll
        for (int r = 0; r < 16; ++r) tile[((tid >> 6) + 8 * r) * 65 + (tid & 63)] = v[r];
        lds_barrier();
        const int tn = t + gridDim.x; const bool more = tn < ntask; WtTask nxt = cur;
        if (more) { nxt = wt_task(p, tn); wt_load(nxt, v); }
        { const int j = tid >> 3, ic = tid & 7, n = cur.nt * 64 + j;
          if (n < cur.N && cur.mode && n >= 4112) {
              unsigned qq[4];
#pragma unroll
              for (int g4 = 0; g4 < 4; ++g4) { const int kb = ic * 16 + g4 * 4; unsigned q8 = __builtin_amdgcn_cvt_pk_fp8_f32(tile[(kb + 0) * 65 + j] * 64.f, tile[(kb + 1) * 65 + j] * 64.f, 0, false);
                  q8 = __builtin_amdgcn_cvt_pk_fp8_f32(tile[(kb + 2) * 65 + j] * 64.f, tile[(kb + 3) * 65 + j] * 64.f, q8, true); qq[g4] = q8; }
              *(u32x4*)(p.ws + WS_WG8 + (size_t)(n - 4112) * 2048 + cur.kt * 128 + ic * 16) = (u32x4){qq[0], qq[1], qq[2], qq[3]};
          } else
          if (n < cur.N) { const int drow = cur.mode ? (n < 3072 ? n : (n < 4096 ? n + 256 : (n < 4112 ? n - 1024 : n + 240))) : n;
              bf16_t* dp = cur.dst + (size_t)drow * cur.K + cur.kt * 128 + ic * 16;
#pragma unroll
              for (int hh = 0; hh < 2; ++hh) { const int kb = ic * 16 + hh * 8; u32x4 w;
                  w.x = pack2(tile[(kb + 0) * 65 + j], tile[(kb + 1) * 65 + j]); w.y = pack2(tile[(kb + 2) * 65 + j], tile[(kb + 3) * 65 + j]);
                  w.z = pack2(tile[(kb + 4) * 65 + j], tile[(kb + 5) * 65 + j]); w.w = pack2(tile[(kb + 6) * 65 + j], tile[(kb + 7) * 65 + j]);
                  *(u32x4*)(dp + hh * 8) = w; } } }
        if (!more) break;
        cur = nxt; t = tn; ++it;
    }
    lds_barrier();
}
__device__ __forceinline__ void rms_rows(const float* __restrict__ src, const float* __restrict__ w, bf16_t* __restrict__ dst, unsigned* __restrict__ dst8) {
    const int lane = threadIdx.x & 63, gw = blockIdx.x * 8 + (threadIdx.x >> 6), nw = gridDim.x * 8;
    for (int row = gw; row < T; row += 2 * nw) {
        const int row2 = row + nw; const bool has2 = row2 < T;
        const f32x4* s0 = (const f32x4*)(src + (size_t)row * DM); const f32x4* s1 = (const f32x4*)(src + (size_t)(has2 ? row2 : row) * DM);
        f32x4 v0[8], v1[8]; float ss0 = 0.f, ss1 = 0.f;
#pragma unroll
        for (int i = 0; i < 8; ++i) { v0[i] = s0[lane + 64 * i]; v1[i] = s1[lane + 64 * i]; }
#pragma unroll
        for (int i = 0; i < 8; ++i) { ss0 += v0[i][0] * v0[i][0] + v0[i][1] * v0[i][1] + v0[i][2] * v0[i][2] + v0[i][3] * v0[i][3]; ss1 += v1[i][0] * v1[i][0] + v1[i][1] * v1[i][1] + v1[i][2] * v1[i][2] + v1[i][3] * v1[i][3]; }
        ss0 = wave_sum(ss0); ss1 = wave_sum(ss1);
        const float r0 = __builtin_amdgcn_rsqf(ss0 * (1.0f / DM) + EPS), r1 = __builtin_amdgcn_rsqf(ss1 * (1.0f / DM) + EPS);
#pragma unroll
        for (int i = 0; i < 8; ++i) { const f32x4 ww = ((const f32x4*)w)[lane + 64 * i];
            u32x2 o; o.x = pack2(v0[i][0] * r0 * ww[0], v0[i][1] * r0 * ww[1]); o.y = pack2(v0[i][2] * r0 * ww[2], v0[i][3] * r0 * ww[3]);
            *(u32x2*)(dst + (size_t)row * DM + (lane + 64 * i) * 4) = o;
            { unsigned q8 = __builtin_amdgcn_cvt_pk_fp8_f32(v0[i][0] * r0 * ww[0] * 4.f, v0[i][1] * r0 * ww[1] * 4.f, 0, false); q8 = __builtin_amdgcn_cvt_pk_fp8_f32(v0[i][2] * r0 * ww[2] * 4.f, v0[i][3] * r0 * ww[3] * 4.f, q8, true); dst8[(size_t)row * (DM / 4) + lane + 64 * i] = q8; }
            if (has2) { u32x2 o2; o2.x = pack2(v1[i][0] * r1 * ww[0], v1[i][1] * r1 * ww[1]); o2.y = pack2(v1[i][2] * r1 * ww[2], v1[i][3] * r1 * ww[3]);
                *(u32x2*)(dst + (size_t)row2 * DM + (lane + 64 * i) * 4) = o2;
                unsigned q8 = __builtin_amdgcn_cvt_pk_fp8_f32(v1[i][0] * r1 * ww[0] * 4.f, v1[i][1] * r1 * ww[1] * 4.f, 0, false); q8 = __builtin_amdgcn_cvt_pk_fp8_f32(v1[i][2] * r1 * ww[2] * 4.f, v1[i][3] * r1 * ww[3] * 4.f, q8, true); dst8[(size_t)row2 * (DM / 4) + lane + 64 * i] = q8; } }
    }
}
__device__ __forceinline__ void phase_prep(const Params& p, LAS unsigned char* lds) {
    unsigned char* ws = p.ws; LAS float* tile = (LAS float*)lds;
    wt_all(p, tile);
    const int gt = blockIdx.x * NTHREADS + threadIdx.x, ngt = gridDim.x * NTHREADS;
    { u32x4* z = (u32x4*)((bf16_t*)(ws + WS_WT_IN) + (size_t)3088 * DM); const int n16 = 240 * DM / 8; for (int i = gt; i < n16; i += ngt) z[i] = (u32x4){0u, 0u, 0u, 0u}; }
    if (blockIdx.x == 0 && threadIdx.x < 4) ((unsigned*)(ws + WS_CTR))[threadIdx.x] = 0u;
    { float* rs = (float*)(ws + WS_ROWSS); for (int i = gt; i < T; i += ngt) rs[i] = 0.f; }
    { f32x2* tab = (f32x2*)(ws + WS_ROPE); const int* pos = (const int*)p.in[1];
      for (int i = gt; i < T * 64; i += ngt) { const double a = (double)pos[i >> 6] * ROPE_REV[i & 63]; const float f = (float)(a - floor(a)); tab[i] = (f32x2){__builtin_amdgcn_cosf(f), __builtin_amdgcn_sinf(f)}; } }
    rms_rows(p.in[0], p.in[2], (bf16_t*)(ws + WS_H), (unsigned*)((unsigned char*)p.out + OUT_H8));
}

struct EpiIn {
    static constexpr bool PERM = true, AFTER_DRAIN = false;
    bf16_t* graw; bf16_t* z; bf16_t* sqkv; bf16_t* gates; float* ab; int pn_base;
    __device__ __forceinline__ void operator()(const f32x4 (&acc)[2][2][4][2], const pg8::Unit& u, int wr, int wc, int fr, int fq) const {
        const int row0 = u.pm * 256 + wr * 64 + fr, pn = u.pn + pn_base;
        if (pn == 12) {
            if (wc == 0 && fq < 2) {
#pragma unroll
                for (int ai = 0; ai < 2; ++ai)
#pragma unroll
                    for (int m = 0; m < 4; ++m) { float* d = ab + (size_t)(row0 + ai * 128 + m * 16) * 16 + 8 * fq; *(f32x4*)d = acc[ai][0][m][0]; *(f32x4*)(d + 4) = acc[ai][0][m][1]; }
            }
            return;
        }
        bf16_t* base; int ld, colt; bool sig = false;
        if (pn < 12) { base = graw; ld = 3072; colt = pn * 256; }
        else if (pn < 17) { base = z; ld = 1024; colt = (pn - 13) * 256; }
        else if (pn < 35) { base = sqkv; ld = 4608; colt = (pn - 17) * 256; }
        else { base = gates; ld = 4096; colt = (pn - 35) * 256; sig = true; }
        const int col0 = colt + wc * 32 + 8 * fq;
#pragma unroll
        for (int ai = 0; ai < 2; ++ai)
#pragma unroll
            for (int m = 0; m < 4; ++m) { bf16_t* rowp = base + (size_t)(row0 + ai * 128 + m * 16) * ld + col0;
#pragma unroll
                for (int bj = 0; bj < 2; ++bj) { f32x4 v0 = acc[ai][bj][m][0], v1 = acc[ai][bj][m][1];
                    if (sig) {
#pragma unroll
                        for (int j = 0; j < 4; ++j) { v0[j] = sigmoidf_(v0[j]); v1[j] = sigmoidf_(v1[j]); } }
                    u32x4 w; w.x = pack2(v0[0], v0[1]); w.y = pack2(v0[2], v0[3]); w.z = pack2(v1[0], v1[1]); w.w = pack2(v1[2], v1[3]);
                    *(u32x4*)(rowp + bj * 128) = w; } }
    }
};
struct EpiVG8 {
    static constexpr bool PERM = true, AFTER_DRAIN = false;
    bf16_t* sqkv; unsigned char* g8;
    __device__ __forceinline__ void operator()(const f32x4 (&acc)[2][2][4][2], const pg8::Unit& u, int wr, int wc, int fr, int fq) const {
        const int row0 = u.pm * 256 + wr * 64 + fr;
        if (u.pn < 18) { const int col0 = u.pn * 256 + wc * 32 + 8 * fq;
#pragma unroll
            for (int ai = 0; ai < 2; ++ai)
#pragma unroll
                for (int m = 0; m < 4; ++m) { bf16_t* rowp = sqkv + (size_t)(row0 + ai * 128 + m * 16) * 4608 + col0;
#pragma unroll
                    for (int bj = 0; bj < 2; ++bj) { const f32x4 v0 = acc[ai][bj][m][0] * (1.0f / 256.0f), v1 = acc[ai][bj][m][1] * (1.0f / 256.0f);
                        *(u32x4*)(rowp + bj * 128) = (u32x4){pack2(v0[0], v0[1]), pack2(v0[2], v0[3]), pack2(v1[0], v1[1]), pack2(v1[2], v1[3])}; } }
            return; }
        const int col0 = (u.pn - 18) * 256 + wc * 32 + 8 * fq;
#pragma unroll
        for (int ai = 0; ai < 2; ++ai)
#pragma unroll
            for (int m = 0; m < 4; ++m) { unsigned char* rowp = g8 + (size_t)(row0 + ai * 128 + m * 16) * 4096 + col0;
#pragma unroll
                for (int bj = 0; bj < 2; ++bj) { const f32x4 v0 = acc[ai][bj][m][0], v1 = acc[ai][bj][m][1]; unsigned lo = 0u, hi = 0u;
#pragma unroll
                    for (int j = 0; j < 4; ++j) { lo |= (unsigned)(sigmoidf_(v0[j] * (1.0f / 256.0f)) * 255.0f + 0.5f) << (8 * j); hi |= (unsigned)(sigmoidf_(v1[j] * (1.0f / 256.0f)) * 255.0f + 0.5f) << (8 * j); }
                    *(u32x2*)(rowp + bj * 128) = (u32x2){lo, hi}; } }
    }
};
struct EpiGate8 {
    static constexpr bool PERM = true, AFTER_DRAIN = false;
    unsigned char* g8;
    __device__ __forceinline__ void operator()(const f32x4 (&acc)[2][2][4][2], const pg8::Unit& u, int wr, int wc, int fr, int fq) const {
        const int row0 = u.pm * 256 + wr * 64 + fr, col0 = u.pn * 256 + wc * 32 + 8 * fq;
#pragma unroll
        for (int ai = 0; ai < 2; ++ai)
#pragma unroll
            for (int m = 0; m < 4; ++m) { unsigned char* rowp = g8 + (size_t)(row0 + ai * 128 + m * 16) * 4096 + col0;
#pragma unroll
                for (int bj = 0; bj < 2; ++bj) { const f32x4 v0 = acc[ai][bj][m][0], v1 = acc[ai][bj][m][1]; unsigned lo = 0u, hi = 0u;
#pragma unroll
                    for (int j = 0; j < 4; ++j) { lo |= (unsigned)(sigmoidf_(v0[j] * (1.0f / 256.0f)) * 255.0f + 0.5f) << (8 * j); hi |= (unsigned)(sigmoidf_(v1[j] * (1.0f / 256.0f)) * 255.0f + 0.5f) << (8 * j); }
                    *(u32x2*)(rowp + bj * 128) = (u32x2){lo, hi}; } }
    }
};
struct EpiMix {
    static constexpr bool PERM = true, AFTER_DRAIN = false;
    const unsigned char* gates; int goff; bf16_t* mixed; int first;
    __device__ __forceinline__ void operator()(const f32x4 (&acc)[2][2][4][2], const pg8::Unit& u, int wr, int wc, int fr, int fq) const {
        const int row0 = u.pm * 256 + wr * 64 + fr, col0 = u.pn * 256 + wc * 32 + 8 * fq;
#pragma unroll
        for (int ai = 0; ai < 2; ++ai) {
            u32x2 g[4][2]; u32x4 o[4][2];
#pragma unroll
            for (int m = 0; m < 4; ++m)
#pragma unroll
                for (int bj = 0; bj < 2; ++bj) { const size_t row = (size_t)(row0 + ai * 128 + m * 16); const int col = col0 + bj * 128;
                    g[m][bj] = *(const u32x2*)(gates + row * 4096 + goff + col); o[m][bj] = first ? (u32x4){0u, 0u, 0u, 0u} : *(const u32x4*)(mixed + row * DM + col); }
#pragma unroll
            for (int m = 0; m < 4; ++m)
#pragma unroll
                for (int bj = 0; bj < 2; ++bj) { const size_t row = (size_t)(row0 + ai * 128 + m * 16); const int col = col0 + bj * 128;
                    f32x4 v0 = acc[ai][bj][m][0], v1 = acc[ai][bj][m][1]; const u32x2 gg = g[m][bj]; const u32x4 oo = o[m][bj]; const float s8 = 1.0f / 255.0f;
                    v0[0] = v0[0] * ((float)(gg.x & 0xffu) * s8) + bflo(oo.x); v0[1] = v0[1] * ((float)((gg.x >> 8) & 0xffu) * s8) + bfhi(oo.x); v0[2] = v0[2] * ((float)((gg.x >> 16) & 0xffu) * s8) + bflo(oo.y); v0[3] = v0[3] * ((float)(gg.x >> 24) * s8) + bfhi(oo.y);
                    v1[0] = v1[0] * ((float)(gg.y & 0xffu) * s8) + bflo(oo.z); v1[1] = v1[1] * ((float)((gg.y >> 8) & 0xffu) * s8) + bfhi(oo.z); v1[2] = v1[2] * ((float)((gg.y >> 16) & 0xffu) * s8) + bflo(oo.w); v1[3] = v1[3] * ((float)(gg.y >> 24) * s8) + bfhi(oo.w);
                    u32x4 w; w.x = pack2(v0[0], v0[1]); w.y = pack2(v0[2], v0[3]); w.z = pack2(v1[0], v1[1]); w.w = pack2(v1[2], v1[3]);
                    *(u32x4*)(mixed + row * DM + col) = w; }
        }
    }
};
struct EpiRes {
    static constexpr bool PERM = false, AFTER_DRAIN = false;
    const float* base; float* out;
    __device__ __forceinline__ void operator()(const f32x4 (&acc)[2][2][4][2], const pg8::Unit& u, int wr, int wc, int fr, int fq) const {
        const int row0 = u.pm * 256 + wr * 64 + fr, col0 = u.pn * 256 + wc * 32 + 4 * fq;
#pragma unroll
        for (int ai = 0; ai < 2; ++ai) {
            f32x4 b[4][2][2];
#pragma unroll
            for (int m = 0; m < 4; ++m)
#pragma unroll
                for (int bj = 0; bj < 2; ++bj)
#pragma unroll
                    for (int n = 0; n < 2; ++n) b[m][bj][n] = *(const f32x4*)(base + (size_t)(row0 + ai * 128 + m * 16) * DM + col0 + bj * 128 + n * 16);
#pragma unroll
            for (int m = 0; m < 4; ++m)
#pragma unroll
                for (int bj = 0; bj < 2; ++bj)
#pragma unroll
                    for (int n = 0; n < 2; ++n) *(f32x4*)(out + (size_t)(row0 + ai * 128 + m * 16) * DM + col0 + bj * 128 + n * 16) = b[m][bj][n] + acc[ai][bj][m][n];
        }
    }
};
struct EpiResB {
    static constexpr bool PERM = false, AFTER_DRAIN = false;
    const bf16_t* base; float* out;
    __device__ __forceinline__ void operator()(const f32x4 (&acc)[2][2][4][2], const pg8::Unit& u, int wr, int wc, int fr, int fq) const {
        const int row0 = u.pm * 256 + wr * 64 + fr, col0 = u.pn * 256 + wc * 32 + 4 * fq;
#pragma unroll
        for (int ai = 0; ai < 2; ++ai) {
            u32x2 b[4][2][2];
#pragma unroll
            for (int m = 0; m < 4; ++m)
#pragma unroll
                for (int bj = 0; bj < 2; ++bj)
#pragma unroll
                    for (int n = 0; n < 2; ++n) b[m][bj][n] = *(const u32x2*)(base + (size_t)(row0 + ai * 128 + m * 16) * DM + col0 + bj * 128 + n * 16);
#pragma unroll
            for (int m = 0; m < 4; ++m)
#pragma unroll
                for (int bj = 0; bj < 2; ++bj)
#pragma unroll
                    for (int n = 0; n < 2; ++n) { const u32x2 bb = b[m][bj][n]; const f32x4 xv = {bflo(bb.x), bfhi(bb.x), bflo(bb.y), bfhi(bb.y)};
                        *(f32x4*)(out + (size_t)(row0 + ai * 128 + m * 16) * DM + col0 + bj * 128 + n * 16) = xv + acc[ai][bj][m][n]; }
        }
    }
};
struct EpiOut {
    static constexpr bool PERM = false, AFTER_DRAIN = false;
    const float* base; float* out; bf16_t* x1b; float* rowss;
    __device__ __forceinline__ void operator()(const f32x4 (&acc)[2][2][4][2], const pg8::Unit& u, int wr, int wc, int fr, int fq) const {
        const int row0 = u.pm * 256 + wr * 64 + fr, col0 = u.pn * 256 + wc * 32 + 4 * fq;
#pragma unroll
        for (int ai = 0; ai < 2; ++ai) {
            f32x4 b[4][2][2];
#pragma unroll
            for (int m = 0; m < 4; ++m)
#pragma unroll
                for (int bj = 0; bj < 2; ++bj)
#pragma unroll
                    for (int n = 0; n < 2; ++n) b[m][bj][n] = *(const f32x4*)(base + (size_t)(row0 + ai * 128 + m * 16) * DM + col0 + bj * 128 + n * 16);
#pragma unroll
            for (int m = 0; m < 4; ++m) { const int row = row0 + ai * 128 + m * 16; const size_t off = (size_t)row * DM + col0; float ss = 0.f;
#pragma unroll
                for (int bj = 0; bj < 2; ++bj)
#pragma unroll
                    for (int n = 0; n < 2; ++n) { const f32x4 v = b[m][bj][n] + acc[ai][bj][m][n];
                        *(u32x2*)(x1b + off + bj * 128 + n * 16) = (u32x2){pack2(v[0], v[1]), pack2(v[2], v[3])}; ss += v[0] * v[0] + v[1] * v[1] + v[2] * v[2] + v[3] * v[3]; }
                ss += __shfl_xor(ss, 16); ss += __shfl_xor(ss, 32);
                if (fq == 0) atomicAdd(rowss + row, ss); }
        }
    }
};
struct EpiRelu2 {
    static constexpr bool PERM = true, AFTER_DRAIN = false;
    bf16_t* U; const float* rowss;
    __device__ __forceinline__ void operator()(const f32x4 (&acc)[2][2][4][2], const pg8::Unit& u, int wr, int wc, int fr, int fq) const {
        const int row0 = u.pm * 256 + wr * 64 + fr, col0 = u.pn * 256 + wc * 32 + 8 * fq;
        float rsv[2][4];
#pragma unroll
        for (int ai = 0; ai < 2; ++ai)
#pragma unroll
            for (int m = 0; m < 4; ++m) rsv[ai][m] = rowss[row0 + ai * 128 + m * 16];
#pragma unroll
        for (int ai = 0; ai < 2; ++ai)
#pragma unroll
            for (int m = 0; m < 4; ++m) { const int row = row0 + ai * 128 + m * 16; bf16_t* rowp = U + (size_t)row * DFF + col0;
                const float rs = __builtin_amdgcn_rsqf(rsv[ai][m] * (1.0f / DM) + EPS);
#pragma unroll
                for (int bj = 0; bj < 2; ++bj) { f32x4 v0 = acc[ai][bj][m][0], v1 = acc[ai][bj][m][1];
#pragma unroll
                    for (int j = 0; j < 4; ++j) { const float a = fmaxf(v0[j] * rs, 0.f), b = fmaxf(v1[j] * rs, 0.f); v0[j] = a * a; v1[j] = b * b; }
                    u32x4 w; w.x = pack2(v0[0], v0[1]); w.y = pack2(v0[2], v0[3]); w.z = pack2(v1[0], v1[1]); w.w = pack2(v1[2], v1[3]);
                    *(u32x4*)(rowp + bj * 128) = w; } }
    }
};
struct ListOrder {
    int nM, nN, nwg, first, stride, count;
    __device__ void init(int M, int N, int first_, int stride_, int count_) { nM = M / pg8::BM; nN = N / pg8::BM; nwg = nM * nN; first = first_; stride = stride_; count = count_; }
    __device__ bool next(int i, pg8::Unit& u) const {
        if (i >= count) return false; const int L = first + i * stride; if (L >= nwg) return false;
        int wgid = L; { const int q = nwg / pg8::NXCD, r = nwg % pg8::NXCD, xcd = wgid % pg8::NXCD, off = wgid / pg8::NXCD; wgid = (xcd < r ? xcd * (q + 1) : r * (q + 1) + (xcd - r) * q) + off; }
        const int nig = pg8::WGM * nN, gid = wgid / nig, fm = gid * pg8::WGM, gsz = (nM - fm) < pg8::WGM ? (nM - fm) : pg8::WGM;
        u.pm = fm + ((wgid % nig) % gsz); u.pn = (wgid % nig) / gsz; return true;
    }
    __device__ __forceinline__ void a_ready(const pg8::Unit&) const {}
    __device__ __forceinline__ void done(const pg8::Unit&) const {}
};
template <class Epi> __device__ __forceinline__ void run_gemm_list(LAS unsigned char* lds, const bf16_t* A, const bf16_t* Bt, int M, int N, int K, const Epi& E, int first, int stride, int count) {
    pg8::Gemm g{A, Bt, M, N, K}; ListOrder S; S.init(M, N, first, stride, count);
    pg8::gemm_phase<Epi, ListOrder, false>(lds, g, S, E, nullptr);
}
template <class Epi> __device__ __forceinline__ void run_gemm_f8(LAS unsigned char* lds, const void* A8, const void* Bt8, int M, int N, int Kbytes, const Epi& E, int G, int c) {
    pg8::Gemm g{(const bf16_t*)A8, (const bf16_t*)Bt8, M, N, Kbytes / 2}; pg8::StaticOrder S; S.init(M, N, G, c);
    pg8::gemm_phase<Epi, pg8::StaticOrder, false, true>(lds, g, S, E, nullptr);
}
template <class Epi> __device__ __forceinline__ void run_gemm_sub(LAS unsigned char* lds, const bf16_t* A, const bf16_t* Bt, int M, int N, int K, const Epi& E, int G, int c) {
    pg8::Gemm g{A, Bt, M, N, K}; pg8::StaticOrder S; S.init(M, N, G, c);
    pg8::gemm_phase<Epi, pg8::StaticOrder, false>(lds, g, S, E, nullptr);
}
template <class Epi> __device__ __forceinline__ void run_gemm(LAS unsigned char* lds, const bf16_t* A, const bf16_t* Bt, int M, int N, int K, const Epi& E) {
    pg8::Gemm g{A, Bt, M, N, K}; pg8::StaticOrder S; S.init(M, N, (int)gridDim.x, (int)blockIdx.x);
    pg8::gemm_phase<Epi, pg8::StaticOrder, false>(lds, g, S, E, nullptr);
}

constexpr int KROW = 136;
typedef short s16x4 __attribute__((ext_vector_type(4)));
__device__ __forceinline__ void phase_swa_attn(const Params& p, LAS unsigned char* lds, int ctr_idx = 0) {
    const bf16_t* sq = (const bf16_t*)(p.ws + WS_SQKV); bf16_t* og = (bf16_t*)(p.ws + WS_OG); float* lse_out = (float*)(p.ws + WS_LSE); const f32x4* tab = (const f32x4*)(p.ws + WS_ROPE);
    LAS bf16_t* Ks = (LAS bf16_t*)lds; LAS bf16_t* Vs = Ks + 256 * KROW;
    const int tid = threadIdx.x, w = tid >> 6, lane = tid & 63, m = lane & 15, quad = lane >> 4;
    unsigned* ctr = (unsigned*)(p.ws + WS_CTR) + ctr_idx; LAS int* s_task = (LAS int*)(lds + LDS_BYTES - 16);
    const int kpart = tid & 15;
    float kw[8], kwp[8];
#pragma unroll
    for (int j = 0; j < 8; ++j) { kw[j] = p.in[10][8 * kpart + j]; kwp[j] = p.in[10][8 * (kpart ^ 8) + j]; }
    for (;;) {
        lds_barrier(); if (tid == 0) *s_task = (int)atomicAdd(ctr, 1u); lds_barrier(); const int item = *s_task; if (item >= 768) break;
        const int b = item / 384; int rem = item % 384; const int g = rem / 128; rem %= 128; const int hh = rem / 32, idx = rem % 32;
        const int dil = 1 << (2 * g), nrun = 32 >> (2 * g), r = idx / nrun, lblk0 = (idx % nrun) * 4, head = g * 4 + hh;
        for (int it = 0; it < 4; ++it) {
            const int lblk = lblk0 + it, l0 = lblk * 128;
            if (it) lds_barrier();
            const int nload = (it == 0) ? 2 : 1;
            for (int ld = 0; ld < nload; ++ld) {
                const int blk = (it == 0) ? lblk - 1 + ld : lblk, slot = blk & 1;
                u32x4 kv[4], vv[4]; f32x4 cs[4][4];
#pragma unroll
                for (int i = 0; i < 4; ++i) { const int ch = tid + NTHREADS * i, c = ch >> 4, lk = blk * 128 + c; kv[i] = (u32x4){0u, 0u, 0u, 0u}; vv[i] = kv[i];
#pragma unroll
                    for (int j = 0; j < 4; ++j) cs[i][j] = (f32x4){0.f, 0.f, 0.f, 0.f};
                    if (lk >= 0) { const size_t tok = (size_t)(b * SEQ + lk * dil + r); const bf16_t* rowp = sq + tok * 4608 + head * 128 + kpart * 8; kv[i] = *(const u32x4*)(rowp + 1536); vv[i] = *(const u32x4*)(rowp + 3072);
                        const f32x4* tp = tab + tok * 32 + 4 * (kpart & 7);
#pragma unroll
                        for (int j = 0; j < 4; ++j) cs[i][j] = tp[j]; } }
#pragma unroll
                for (int i = 0; i < 4; ++i) { const int ch = tid + NTHREADS * i, c = ch >> 4, row = slot * 128 + c;
                    float x[8], px[8];
                    x[0] = bflo(kv[i].x); x[1] = bfhi(kv[i].x); x[2] = bflo(kv[i].y); x[3] = bfhi(kv[i].y); x[4] = bflo(kv[i].z); x[5] = bfhi(kv[i].z); x[6] = bflo(kv[i].w); x[7] = bfhi(kv[i].w);
                    float ss = 0.f;
#pragma unroll
                    for (int j = 0; j < 8; ++j) ss += x[j] * x[j];
                    ss += __shfl_xor(ss, 1); ss += __shfl_xor(ss, 2); ss += __shfl_xor(ss, 4); ss += __shfl_xor(ss, 8);
                    const float rr = __builtin_amdgcn_rsqf(ss * (1.0f / 128.0f) + EPS);
                    const unsigned p0 = __shfl_xor(kv[i].x, 8), p1 = __shfl_xor(kv[i].y, 8), p2 = __shfl_xor(kv[i].z, 8), p3 = __shfl_xor(kv[i].w, 8);
                    px[0] = bflo(p0); px[1] = bfhi(p0); px[2] = bflo(p1); px[3] = bfhi(p1); px[4] = bflo(p2); px[5] = bfhi(p2); px[6] = bflo(p3); px[7] = bfhi(p3);
                    const float sgn = (kpart < 8) ? -1.f : 1.f; float o[8];
#pragma unroll
                    for (int j = 0; j < 8; ++j) { const float co = cs[i][j >> 1][2 * (j & 1)], si = cs[i][j >> 1][2 * (j & 1) + 1]; const float y = x[j] * rr * kw[j], py = px[j] * rr * kwp[j]; o[j] = y * co + sgn * py * si; }
                    *(LAS u32x4*)(Ks + row * KROW + kpart * 8) = (u32x4){pack2(o[0], o[1]), pack2(o[2], o[3]), pack2(o[4], o[5]), pack2(o[6], o[7])};
                    *(LAS u32x4*)(Vs + row * KROW + kpart * 8) = vv[i]; }
            }
            const int qtok = b * SEQ + (l0 + 16 * w + m) * dil + r;
            u32x4 qf[4];
            {   u32x4 qr_[4];
#pragma unroll
                for (int ks = 0; ks < 4; ++ks) qr_[ks] = *(const u32x4*)(sq + (size_t)qtok * 4608 + head * 128 + ks * 32 + quad * 8);
                float x[4][8]; float ss = 0.f;
#pragma unroll
                for (int ks = 0; ks < 4; ++ks) { x[ks][0] = bflo(qr_[ks].x); x[ks][1] = bfhi(qr_[ks].x); x[ks][2] = bflo(qr_[ks].y); x[ks][3] = bfhi(qr_[ks].y); x[ks][4] = bflo(qr_[ks].z); x[ks][5] = bfhi(qr_[ks].z); x[ks][6] = bflo(qr_[ks].w); x[ks][7] = bfhi(qr_[ks].w);
#pragma unroll
                    for (int j = 0; j < 8; ++j) ss += x[ks][j] * x[ks][j]; }
                ss += __shfl_xor(ss, 16); ss += __shfl_xor(ss, 32);
                const float rr = (0.08838834764831845f * __builtin_amdgcn_rsqf(ss * (1.0f / 128.0f) + EPS));
                float o[4][8];
#pragma unroll
                for (int ks = 0; ks < 2; ++ks) { const f32x4* tp = tab + (size_t)qtok * 32 + 16 * ks + 4 * quad;
#pragma unroll
                    for (int j4 = 0; j4 < 4; ++j4) { const f32x4 c4 = tp[j4];
#pragma unroll
                        for (int jj = 0; jj < 2; ++jj) { const int j = 2 * j4 + jj, d = 32 * ks + 8 * quad + j; const float co = c4[2 * jj], si = c4[2 * jj + 1];
                            const float y = x[ks][j] * rr * p.in[9][d], py = x[ks + 2][j] * rr * p.in[9][d + 64]; o[ks][j] = y * co - py * si; o[ks + 2][j] = py * co + y * si; } } }
#pragma unroll
                for (int ks = 0; ks < 4; ++ks) qf[ks] = (u32x4){pack2(o[ks][0], o[ks][1]), pack2(o[ks][2], o[ks][3]), pack2(o[ks][4], o[ks][5]), pack2(o[ks][6], o[ks][7])};
            }
            lds_barrier();
#define KROWBASE(kb) (((((lblk - 1 + ((kb) >> 3)) & 1) << 7) + 16 * ((kb) & 7)))
            f32x4 sc[10]; float mx = -3e38f;
#pragma unroll
            for (int t = 0; t < 9; ++t) { const int kb = w + t, rb = KROWBASE(kb); f32x4 acc = {0.f, 0.f, 0.f, 0.f};
#pragma unroll
                for (int ks = 0; ks < 4; ++ks) { const u32x4 a = *(const LAS u32x4*)(Ks + (rb + m) * KROW + ks * 32 + quad * 8); acc = mfma16(a, qf[ks], acc); }
#pragma unroll
                for (int j = 0; j < 4; ++j) { const int kk = 4 * quad + j; bool ok = (l0 > 0) || (16 * kb + kk >= 128);
                    if (t == 0) ok = ok && (kk >= m); if (t == 8) ok = ok && (kk <= m);
                    acc[j] = ok ? acc[j] : -1e30f; mx = fmaxf(mx, acc[j]); }
                sc[t] = acc; }
            mx = fmaxf(mx, __shfl_xor(mx, 16)); mx = fmaxf(mx, __shfl_xor(mx, 32));
            float sum = 0.f;
#pragma unroll
            for (int t = 0; t < 9; ++t)
#pragma unroll
                for (int j = 0; j < 4; ++j) { const float e = __expf(sc[t][j] - mx); sc[t][j] = e; sum += e; }
            sc[9] = (f32x4){0.f, 0.f, 0.f, 0.f};
            sum += __shfl_xor(sum, 16); sum += __shfl_xor(sum, 32);
            const float inv = 1.0f / sum;
            u32x4 Pb[5];
#pragma unroll
            for (int u = 0; u < 5; ++u) Pb[u] = (u32x4){pack2(sc[2 * u][0], sc[2 * u][1]), pack2(sc[2 * u][2], sc[2 * u][3]), pack2(sc[2 * u + 1][0], sc[2 * u + 1][1]), pack2(sc[2 * u + 1][2], sc[2 * u + 1][3])};
            bf16_t* op = og + ((size_t)g * T + qtok) * 512 + hh * 128 + 4 * quad;
            const int qr = m >> 2, pp = m & 3;
#pragma unroll
            for (int db = 0; db < 8; ++db) { f32x4 acc = {0.f, 0.f, 0.f, 0.f};
#pragma unroll
                for (int u = 0; u < 5; ++u) { const int kb0 = w + 2 * u, kb1 = (kb0 + 1 < 16) ? kb0 + 1 : kb0; const int rb0 = KROWBASE(kb0), rb1 = KROWBASE(kb1);
                    const s16x4 v0 = __builtin_amdgcn_ds_read_tr16_b64_v4i16((LAS s16x4*)(Vs + (rb0 + 4 * quad + qr) * KROW + 16 * db + 4 * pp));
                    const s16x4 v1 = __builtin_amdgcn_ds_read_tr16_b64_v4i16((LAS s16x4*)(Vs + (rb1 + 4 * quad + qr) * KROW + 16 * db + 4 * pp));
                    const u32x2 a0 = __builtin_bit_cast(u32x2, v0), a1 = __builtin_bit_cast(u32x2, v1);
                    acc = mfma16((u32x4){a0.x, a0.y, a1.x, a1.y}, Pb[u], acc); }
                *(u32x2*)(op + 16 * db) = (u32x2){pack2(acc[0] * inv, acc[1] * inv), pack2(acc[2] * inv, acc[3] * inv)}; }
#undef KROWBASE
            if (quad == 0) lse_out[((size_t)g * T + qtok) * 4 + hh] = mx + __logf(sum);
        }
    }
}
__device__ __forceinline__ void phase_swa_combine(const Params& p) {
    const bf16_t* og = (const bf16_t*)(p.ws + WS_OG); const float* lse = (const float*)(p.ws + WS_LSE); bf16_t* ob = (bf16_t*)(p.ws + WS_OB);
    for (int it = blockIdx.x * NTHREADS + threadIdx.x; it < T * 64; it += gridDim.x * NTHREADS) {
        const int tok = it >> 6, hh = (it >> 4) & 3, ch = it & 15;
        const float l0 = lse[((size_t)0 * T + tok) * 4 + hh], l1 = lse[((size_t)1 * T + tok) * 4 + hh], l2 = lse[((size_t)2 * T + tok) * 4 + hh];
        const float m = fmaxf(l0, fmaxf(l1, l2)); float w0 = __expf(l0 - m), w1 = __expf(l1 - m), w2 = __expf(l2 - m); const float inv = 1.0f / (w0 + w1 + w2); w0 *= inv; w1 *= inv; w2 *= inv;
        const size_t off = (size_t)tok * 512 + hh * 128 + ch * 8;
        const u32x4 a = *(const u32x4*)(og + off), b = *(const u32x4*)(og + (size_t)T * 512 + off), c = *(const u32x4*)(og + (size_t)2 * T * 512 + off);
        u32x4 o;
        o.x = pack2(w0 * bflo(a.x) + w1 * bflo(b.x) + w2 * bflo(c.x), w0 * bfhi(a.x) + w1 * bfhi(b.x) + w2 * bfhi(c.x));
        o.y = pack2(w0 * bflo(a.y) + w1 * bflo(b.y) + w2 * bflo(c.y), w0 * bfhi(a.y) + w1 * bfhi(b.y) + w2 * bfhi(c.y));
        o.z = pack2(w0 * bflo(a.z) + w1 * bflo(b.z) + w2 * bflo(c.z), w0 * bfhi(a.z) + w1 * bfhi(b.z) + w2 * bfhi(c.z));
        o.w = pack2(w0 * bflo(a.w) + w1 * bflo(b.w) + w2 * bflo(c.w), w0 * bfhi(a.w) + w1 * bfhi(b.w) + w2 * bfhi(c.w));
        *(u32x4*)(ob + off) = o;
    }
}

constexpr int QROW = 136, TROW = 72, AROW = 68;
constexpr int L_QN = 0, L_KN = L_QN + 64 * QROW * 2, L_VN = L_KN + 64 * QROW * 2, L_AKK = L_VN + 64 * QROW * 2, L_TU = L_AKK + 64 * AROW * 4,
              L_TW = L_TU + 64 * TROW * 2, L_QKM = L_TW + 64 * TROW * 2, L_GS = L_QKM + 64 * TROW * 2, L_BS = L_GS + 256, L_GR = L_BS + 256, L_TF = L_GR + 256, L_AB = L_TF + 64 * AROW * 4, L_PREP_END = L_AB + 64 * 16 * 4;
static_assert(L_PREP_END <= LDS_BYTES, "prep LDS");

__device__ __forceinline__ void gdn_ab_block(const Params& p, LAS unsigned char* lds, int tok0) {
    const bf16_t* H = (const bf16_t*)(p.ws + WS_H); const bf16_t* Wab = (const bf16_t*)(p.ws + WS_WT_IN) + (size_t)3072 * DM;
    LAS float* abs_ = (LAS float*)(lds + L_AB);
    const int tid = threadIdx.x, w = tid >> 6, lane = tid & 63, m = lane & 15, q = lane >> 4;
    lds_barrier();
    if (w < 4) {
        const bf16_t* ap = H + (size_t)(tok0 + 16 * w + m) * DM + q * 8; const bf16_t* bp = Wab + (size_t)m * DM + q * 8;
        f32x4 acc0 = {0.f, 0.f, 0.f, 0.f}, acc1 = {0.f, 0.f, 0.f, 0.f};
#pragma unroll 4
        for (int ks = 0; ks < 64; ks += 2) { const u32x4 a0 = *(const u32x4*)(ap + ks * 32), b0 = *(const u32x4*)(bp + ks * 32), a1 = *(const u32x4*)(ap + ks * 32 + 32), b1 = *(const u32x4*)(bp + ks * 32 + 32);
            acc0 = mfma16(a0, b0, acc0); acc1 = mfma16(a1, b1, acc1); }
#pragma unroll
        for (int j = 0; j < 4; ++j) abs_[(16 * w + 4 * q + j) * 16 + m] = acc0[j] + acc1[j];
    }
    lds_barrier();
}
struct PrepRaw { unsigned x[3][11]; f32x2 cw[3][4]; float a, b; };
__device__ __forceinline__ void gdn_prep_load(const Params& p, int chunk, PrepRaw& R) {
    const bf16_t* graw = (const bf16_t*)(p.ws + WS_GRAW); const float* ab = (const float*)(p.ws + WS_AB); const float* cw = p.in[4];
    const int tid = threadIdx.x, w = tid >> 6, lane = tid & 63;
    const int b = chunk >> 11, h = (chunk >> 8) & 7, n = chunk & 255, t0 = n * 64, tok0 = b * SEQ + t0;
#pragma unroll
    for (int part = 0; part < 3; ++part) { const int col = part * 1024 + h * 128 + 2 * lane;
#pragma unroll
        for (int j = 0; j < 4; ++j) R.cw[part][j] = *(const f32x2*)(cw + j * 3072 + col);
#pragma unroll
        for (int i = 0; i < 11; ++i) { const int tt = w * 8 - 3 + i; R.x[part][i] = (t0 + tt >= 0) ? *(const unsigned*)(graw + (size_t)(tok0 + tt) * 3072 + col) : 0u; } }
    R.a = 0.f; R.b = 0.f;
}
__device__ __forceinline__ void gdn_prep_chunk(const Params& p, LAS unsigned char* lds, int chunk, PrepRaw& R, int next_chunk) {
    const bf16_t* graw = (const bf16_t*)(p.ws + WS_GRAW); const float* ab = (const float*)(p.ws + WS_AB); const float* cw = p.in[4];
    LAS bf16_t* qn = (LAS bf16_t*)(lds + L_QN); LAS bf16_t* kn = (LAS bf16_t*)(lds + L_KN); LAS bf16_t* vn = (LAS bf16_t*)(lds + L_VN);
    LAS float* Akk = (LAS float*)(lds + L_AKK); LAS bf16_t* Tu = (LAS bf16_t*)(lds + L_TU); LAS bf16_t* Tw = (LAS bf16_t*)(lds + L_TW); LAS bf16_t* QKm = (LAS bf16_t*)(lds + L_QKM);
    LAS float* Tf = (LAS float*)(lds + L_TF);
    LAS float* Gs = (LAS float*)(lds + L_GS); LAS float* bs = (LAS float*)(lds + L_BS); LAS float* gr = (LAS float*)(lds + L_GR);
    int tid_ = threadIdx.x; asm volatile("" : "+v"(tid_));
    const int tid = tid_, w = __builtin_amdgcn_readfirstlane(tid >> 6), lane = tid & 63, m = lane & 15, q = lane >> 4;
    const int b = chunk >> 11, h = (chunk >> 8) & 7, n = chunk & 255, t0 = n * 64, tok0 = b * SEQ + t0;
    LAS float* abs_ = (LAS float*)(lds + L_AB);
    float ab_a = 0.f, ab_b = 0.f; if (tid < 64) { ab_a = abs_[tid * 16 + h]; ab_b = abs_[tid * 16 + 8 + h]; }
    lds_barrier();
#pragma unroll
    for (int part = 0; part < 3; ++part) {
        const f32x2 (&cwv)[4] = R.cw[part]; const unsigned (&x)[11] = R.x[part];
#pragma unroll
        for (int k = 0; k < 8; ++k) {
            float y0 = 0.f, y1 = 0.f;
#pragma unroll
            for (int j = 0; j < 4; ++j) { y0 += cwv[j][0] * bflo(x[k + j]); y1 += cwv[j][1] * bfhi(x[k + j]); }
            y0 = siluf_(y0); y1 = siluf_(y1);
            const int tl = w * 8 + k;
            if (part == 0) { const float ss = wave_sum(y0 * y0 + y1 * y1), r = (0.08838834764831845f * __builtin_amdgcn_rsqf(ss + EPS)); *(LAS unsigned*)(qn + tl * QROW + 2 * lane) = pack2(y0 * r, y1 * r); }
            else if (part == 1) { const float ss = wave_sum(y0 * y0 + y1 * y1), r = __builtin_amdgcn_rsqf(ss + EPS); const unsigned pk = pack2(y0 * r, y1 * r);
                *(LAS unsigned*)(kn + tl * QROW + 2 * lane) = pk; }
            else { *(LAS unsigned*)(vn + tl * QROW + 2 * lane) = pack2(y0, y1); }
        }
    }
    if (next_chunk < 4096) gdn_prep_load(p, next_chunk, R);
    if (tid < 64) { const float xx = ab_a + p.in[6][h];
        const float sp = xx > 20.f ? xx : log1pf(expf(xx)); gr[tid] = -expf(p.in[5][h]) * sp; bs[tid] = 1.0f / (1.0f + expf(-ab_b)); }
    lds_barrier();
    if (tid < 64) { float G0 = 0.f, G1 = 0.f, G2 = 0.f, G3 = 0.f; int tq = tid; asm volatile("" : "+v"(tq));
#pragma unroll
        for (int j4 = 0; j4 < 16; ++j4) { const f32x4 gv = *(const LAS f32x4*)(gr + 4 * j4); G0 += (4 * j4 <= tq) ? gv[0] : 0.f; G1 += (4 * j4 + 1 <= tq) ? gv[1] : 0.f; G2 += (4 * j4 + 2 <= tq) ? gv[2] : 0.f; G3 += (4 * j4 + 3 <= tq) ? gv[3] : 0.f; }
        const float G = (G0 + G1) + (G2 + G3); Gs[tid] = G; if (tid == 63) ((float*)(p.ws + WS_GDEC))[chunk] = expf(G); }
    lds_barrier();
    { const int ib = w >> 1;
#pragma unroll
      for (int j2 = 0; j2 < 2; ++j2) { const int jb = 2 * (w & 1) + j2; f32x4 akk = {0.f, 0.f, 0.f, 0.f}, aqk = {0.f, 0.f, 0.f, 0.f};
#pragma unroll
          for (int ks = 0; ks < 4; ++ks) { const u32x4 bf = *(const LAS u32x4*)(kn + (16 * jb + m) * QROW + ks * 32 + q * 8);
              const u32x4 ak = *(const LAS u32x4*)(kn + (16 * ib + m) * QROW + ks * 32 + q * 8), aq = *(const LAS u32x4*)(qn + (16 * ib + m) * QROW + ks * 32 + q * 8);
              akk = mfma16(ak, bf, akk); aqk = mfma16(aq, bf, aqk); }
          const int j = 16 * jb + m; const float Gj = Gs[j];
#pragma unroll
          for (int jj = 0; jj < 4; ++jj) { const int i = 16 * ib + 4 * q + jj; const float dcy = (i >= j) ? __expf(Gs[i] - Gj) : 0.f;
              Akk[i * AROW + j] = (i > j) ? bs[i] * akk[jj] * dcy : 0.f; QKm[i * TROW + j] = f2bf(aqk[jj] * dcy); } } }
    lds_barrier();
    if (w == 0) {
        int c = lane & 31; asm volatile("" : "+v"(c));
        const int bo = (lane >> 5) * 32; float Tc[32];
#pragma unroll
        for (int i = 0; i < 32; ++i) Tc[i] = 0.f;
#pragma unroll
        for (int i = 0; i < 32; ++i) { float s0 = (i == c) ? 1.f : 0.f, s1 = 0.f, s2 = 0.f, s3 = 0.f;
#pragma unroll
            for (int j4 = 0; j4 < (i + 3) / 4; ++j4) { const f32x4 a = *(const LAS f32x4*)(Akk + (bo + i) * AROW + bo + 4 * j4); s0 -= a[0] * Tc[4 * j4]; s1 -= a[1] * Tc[4 * j4 + 1]; s2 -= a[2] * Tc[4 * j4 + 2]; s3 -= a[3] * Tc[4 * j4 + 3]; }
            Tc[i] = (s0 + s1) + (s2 + s3); if ((i & 3) == 3) asm volatile("" ::: "memory"); }
#pragma unroll
        for (int i = 0; i < 32; ++i) Tf[(bo + i) * AROW + bo + c] = Tc[i];
    } else {
        u32x4* AF = (u32x4*)(p.ws + WS_AF) + (size_t)chunk * 512; u32x4* QF = (u32x4*)(p.ws + WS_QF) + (size_t)chunk * 1024; u32x4* KF = (u32x4*)(p.ws + WS_KF) + (size_t)chunk * 1024;
        const float Glast = Gs[63];
        for (int ft = w - 1; ft < 40; ft += 7) {
            if (ft < 8) { const int r = ft >> 1, s2 = ft & 1; const LAS bf16_t* bp = QKm + (16 * r + m) * TROW + 32 * s2 + 4 * q;
                const u32x2 lo = *(const LAS u32x2*)bp, hi = *(const LAS u32x2*)(bp + 16); AF[ft * 64 + lane] = (u32x4){lo.x, lo.y, hi.x, hi.y}; }
            else if (ft < 24) { const int f = ft - 8, r = f >> 2, s = f & 3; const LAS bf16_t* bp = qn + (16 * r + m) * QROW + 32 * s + 4 * q;
                const u32x2 lo = *(const LAS u32x2*)bp, hi = *(const LAS u32x2*)(bp + 16); const float sc = __expf(Gs[16 * r + m]);
                QF[f * 64 + lane] = (u32x4){pack2(bflo(lo.x) * sc, bfhi(lo.x) * sc), pack2(bflo(lo.y) * sc, bfhi(lo.y) * sc), pack2(bflo(hi.x) * sc, bfhi(hi.x) * sc), pack2(bflo(hi.y) * sc, bfhi(hi.y) * sc)}; }
            else { const int f = ft - 24, rd = f >> 1, s2 = f & 1; const int tk = 32 * s2 + 4 * q;
                const u32x2 lo = __builtin_bit_cast(u32x2, __builtin_amdgcn_ds_read_tr16_b64_v4i16((LAS s16x4*)(kn + (tk + (m >> 2)) * QROW + 16 * rd + 4 * (m & 3))));
                const u32x2 hi = __builtin_bit_cast(u32x2, __builtin_amdgcn_ds_read_tr16_b64_v4i16((LAS s16x4*)(kn + (tk + 16 + (m >> 2)) * QROW + 16 * rd + 4 * (m & 3))));
                const float e0 = __expf(Glast - Gs[tk]), e1 = __expf(Glast - Gs[tk + 1]), e2 = __expf(Glast - Gs[tk + 2]), e3 = __expf(Glast - Gs[tk + 3]);
                const float e4 = __expf(Glast - Gs[tk + 16]), e5 = __expf(Glast - Gs[tk + 17]), e6 = __expf(Glast - Gs[tk + 18]), e7 = __expf(Glast - Gs[tk + 19]);
                KF[f * 64 + lane] = (u32x4){pack2(bflo(lo.x) * e0, bfhi(lo.x) * e1), pack2(bflo(lo.y) * e2, bfhi(lo.y) * e3), pack2(bflo(hi.x) * e4, bfhi(hi.x) * e5), pack2(bflo(hi.y) * e6, bfhi(hi.y) * e7)}; }
        }
    }
    lds_barrier();
    {
        const int c = tid & 31, i0 = tid >> 5; float x0 = 0.f, x1 = 0.f;
#pragma unroll
        for (int j4 = 0; j4 < 8; ++j4) { const f32x4 a0 = *(const LAS f32x4*)(Akk + (32 + i0) * AROW + 4 * j4), a1 = *(const LAS f32x4*)(Akk + (48 + i0) * AROW + 4 * j4);
#pragma unroll
            for (int jj = 0; jj < 4; ++jj) { const float t = Tf[(4 * j4 + jj) * AROW + c]; x0 += a0[jj] * t; x1 += a1[jj] * t; } }
        Tf[(32 + i0) * AROW + c] = x0; Tf[(48 + i0) * AROW + c] = x1;
    }
    lds_barrier();
    {
        const int c = tid & 31, i0 = tid >> 5; float y0 = 0.f, y1 = 0.f;
#pragma unroll
        for (int k4 = 0; k4 < 8; ++k4) { const f32x4 a0 = *(const LAS f32x4*)(Tf + (32 + i0) * AROW + 32 + 4 * k4), a1 = *(const LAS f32x4*)(Tf + (48 + i0) * AROW + 32 + 4 * k4);
#pragma unroll
            for (int kk = 0; kk < 4; ++kk) { const float xk = Tf[(32 + 4 * k4 + kk) * AROW + c]; y0 -= a0[kk] * xk; y1 -= a1[kk] * xk; } }
        const float cb0 = bs[c], ce0 = cb0 * __expf(Gs[c]), cb1 = bs[32 + c], ce1 = cb1 * __expf(Gs[32 + c]);
        Tu[(32 + i0) * TROW + c] = f2bf(y0 * cb0); Tw[(32 + i0) * TROW + c] = f2bf(y0 * ce0); Tu[(48 + i0) * TROW + c] = f2bf(y1 * cb0); Tw[(48 + i0) * TROW + c] = f2bf(y1 * ce0);
        const float d00 = Tf[i0 * AROW + c], d01 = Tf[(16 + i0) * AROW + c], d10 = Tf[(32 + i0) * AROW + 32 + c], d11 = Tf[(48 + i0) * AROW + 32 + c];
        Tu[i0 * TROW + c] = f2bf(d00 * cb0); Tw[i0 * TROW + c] = f2bf(d00 * ce0); Tu[(16 + i0) * TROW + c] = f2bf(d01 * cb0); Tw[(16 + i0) * TROW + c] = f2bf(d01 * ce0);
        Tu[(32 + i0) * TROW + 32 + c] = f2bf(d10 * cb1); Tw[(32 + i0) * TROW + 32 + c] = f2bf(d10 * ce1); Tu[(48 + i0) * TROW + 32 + c] = f2bf(d11 * cb1); Tw[(48 + i0) * TROW + 32 + c] = f2bf(d11 * ce1);
        Tu[i0 * TROW + 32 + c] = 0; Tw[i0 * TROW + 32 + c] = 0; Tu[(16 + i0) * TROW + 32 + c] = 0; Tw[(16 + i0) * TROW + 32 + c] = 0;
    }
    lds_barrier();
    { u32x2* UA = (u32x2*)(p.ws + WS_UACC) + (size_t)chunk * 2048; u32x2* WF2 = (u32x2*)(p.ws + WS_WF) + (size_t)chunk * 2048;
#pragma unroll
      for (int r = 0; r < 4; ++r) { f32x4 acc = {0.f, 0.f, 0.f, 0.f};
#pragma unroll
          for (int ks = 0; ks < 2; ++ks) { const u32x4 a = *(const LAS u32x4*)(Tu + (16 * r + m) * TROW + ks * 32 + q * 8);
              const u32x2 b0 = __builtin_bit_cast(u32x2, __builtin_amdgcn_ds_read_tr16_b64_v4i16((LAS s16x4*)(vn + (ks * 32 + 8 * q + (m >> 2)) * QROW + 16 * w + 4 * (m & 3))));
              const u32x2 b1 = __builtin_bit_cast(u32x2, __builtin_amdgcn_ds_read_tr16_b64_v4i16((LAS s16x4*)(vn + (ks * 32 + 8 * q + 4 + (m >> 2)) * QROW + 16 * w + 4 * (m & 3))));
              acc = mfma16(a, (u32x4){b0.x, b0.y, b1.x, b1.y}, acc); }
          UA[(w * 4 + r) * 64 + lane] = (u32x2){pack2(acc[0], acc[1]), pack2(acc[2], acc[3])}; }
#pragma unroll
      for (int ib = 0; ib < 4; ++ib) { f32x4 acc = {0.f, 0.f, 0.f, 0.f};
#pragma unroll
          for (int ks = 0; ks < 2; ++ks) { const u32x4 bb = *(const LAS u32x4*)(Tw + (16 * ib + m) * TROW + ks * 32 + q * 8);
              const u32x2 a0 = __builtin_bit_cast(u32x2, __builtin_amdgcn_ds_read_tr16_b64_v4i16((LAS s16x4*)(kn + (ks * 32 + 8 * q + (m >> 2)) * QROW + 16 * w + 4 * (m & 3))));
              const u32x2 a1 = __builtin_bit_cast(u32x2, __builtin_amdgcn_ds_read_tr16_b64_v4i16((LAS s16x4*)(kn + (ks * 32 + 8 * q + 4 + (m >> 2)) * QROW + 16 * w + 4 * (m & 3))));
              acc = mfma16((u32x4){a0.x, a0.y, a1.x, a1.y}, bb, acc); }
          WF2[((ib * 4 + (w >> 1)) * 64 + lane) * 2 + (w & 1)] = (u32x2){pack2(-acc[0], -acc[1]), pack2(-acc[2], -acc[3])}; } }
}

constexpr int SC_WF = 0, SC_QF = 1024, SC_AF = 2048, SC_KF = 2560, SC_N = 3584;
__device__ __forceinline__ void gdn_scan(const Params& p, LAS unsigned char* lds, int bh) {
    const int tid = threadIdx.x, w = tid >> 6, lane = tid & 63;
    const int cb = bh * 256;
    const u32x4* WFg = (const u32x4*)(p.ws + WS_WF); const u32x4* QFg = (const u32x4*)(p.ws + WS_QF); const u32x4* AFg = (const u32x4*)(p.ws + WS_AF); const u32x4* KFg = (const u32x4*)(p.ws + WS_KF);
    const u32x2* UA = (const u32x2*)(p.ws + WS_UACC); u32x2* OR = (u32x2*)(p.ws + WS_ORAW); const float* gdec = (const float*)(p.ws + WS_GDEC);
    LAS u32x4* buf = (LAS u32x4*)lds;
    lds_barrier();
    if (w >= 4) {
        const int lt = tid - 256; u32x4 rg[14];
#define SC_LOAD(ch) do { const size_t c_ = (size_t)(cb + (ch)); _Pragma("unroll") for (int i_ = 0; i_ < 4; ++i_) { rg[i_] = WFg[c_ * 1024 + i_ * 256 + lt]; rg[4 + i_] = QFg[c_ * 1024 + i_ * 256 + lt]; rg[10 + i_] = KFg[c_ * 1024 + i_ * 256 + lt]; } \
        rg[8] = AFg[c_ * 512 + lt]; rg[9] = AFg[c_ * 512 + 256 + lt]; } while (0)
#define SC_WRITE(bi) do { LAS u32x4* d_ = buf + (bi) * SC_N; _Pragma("unroll") for (int i_ = 0; i_ < 4; ++i_) { d_[SC_WF + i_ * 256 + lt] = rg[i_]; d_[SC_QF + i_ * 256 + lt] = rg[4 + i_]; d_[SC_KF + i_ * 256 + lt] = rg[10 + i_]; } \
        d_[SC_AF + lt] = rg[8]; d_[SC_AF + 256 + lt] = rg[9]; } while (0)
        SC_LOAD(0); SC_WRITE(0); SC_LOAD(1);
        lds_barrier();
        for (int n = 0; n < 256; ++n) {
            if (n + 1 < 256) SC_WRITE((n + 1) & 1);
            if (n + 2 < 256) SC_LOAD(n + 2);
            lds_barrier();
        }
#undef SC_LOAD
#undef SC_WRITE
    } else {
        f32x4 S[8][2]; u32x4 Sbf[4][2];
#pragma unroll
        for (int i = 0; i < 8; ++i) { S[i][0] = (f32x4){0.f, 0.f, 0.f, 0.f}; S[i][1] = (f32x4){0.f, 0.f, 0.f, 0.f}; }
#pragma unroll
        for (int i = 0; i < 4; ++i) { Sbf[i][0] = (u32x4){0u, 0u, 0u, 0u}; Sbf[i][1] = (u32x4){0u, 0u, 0u, 0u}; }
        u32x2 ub[2][4]; float dec;
#pragma unroll
        for (int nb = 0; nb < 2; ++nb)
#pragma unroll
            for (int r = 0; r < 4; ++r) ub[nb][r] = UA[(size_t)cb * 2048 + ((2 * w + nb) * 4 + r) * 64 + lane];
        dec = gdec[cb];
        lds_barrier();
        for (int n = 0; n < 256; ++n) {
            const LAS u32x4* B = buf + (n & 1) * SC_N;
            f32x4 vn[4][2], o[4][2];
#pragma unroll
            for (int r = 0; r < 4; ++r)
#pragma unroll
                for (int nb = 0; nb < 2; ++nb) { const u32x2 u = ub[nb][r]; vn[r][nb] = (f32x4){bflo(u.x), bfhi(u.x), bflo(u.y), bfhi(u.y)}; o[r][nb] = (f32x4){0.f, 0.f, 0.f, 0.f}; }
            const float dcur = dec;
            { const int nn = (n + 1 < 256) ? n + 1 : n;
#pragma unroll
              for (int nb = 0; nb < 2; ++nb)
#pragma unroll
                  for (int r = 0; r < 4; ++r) ub[nb][r] = UA[(size_t)(cb + nn) * 2048 + ((2 * w + nb) * 4 + r) * 64 + lane];
              dec = gdec[cb + nn]; }
#pragma unroll
            for (int r = 0; r < 4; ++r)
#pragma unroll
                for (int s = 0; s < 4; ++s) { const u32x4 aw = B[SC_WF + (r * 4 + s) * 64 + lane], aq = B[SC_QF + (r * 4 + s) * 64 + lane];
                    vn[r][0] = mfma16(aw, Sbf[s][0], vn[r][0]); vn[r][1] = mfma16(aw, Sbf[s][1], vn[r][1]);
                    o[r][0] = mfma16(aq, Sbf[s][0], o[r][0]); o[r][1] = mfma16(aq, Sbf[s][1], o[r][1]); }
            u32x4 Vb[2][2];
#pragma unroll
            for (int s2 = 0; s2 < 2; ++s2)
#pragma unroll
                for (int nb = 0; nb < 2; ++nb) Vb[s2][nb] = (u32x4){pack2(vn[2 * s2][nb][0], vn[2 * s2][nb][1]), pack2(vn[2 * s2][nb][2], vn[2 * s2][nb][3]), pack2(vn[2 * s2 + 1][nb][0], vn[2 * s2 + 1][nb][1]), pack2(vn[2 * s2 + 1][nb][2], vn[2 * s2 + 1][nb][3])};
#pragma unroll
            for (int r = 0; r < 4; ++r)
#pragma unroll
                for (int s2 = 0; s2 < 2; ++s2) { const u32x4 a = B[SC_AF + (r * 2 + s2) * 64 + lane]; o[r][0] = mfma16(a, Vb[s2][0], o[r][0]); o[r][1] = mfma16(a, Vb[s2][1], o[r][1]); }
#pragma unroll
            for (int rd = 0; rd < 8; ++rd) { S[rd][0] *= dcur; S[rd][1] *= dcur;
#pragma unroll
                for (int s2 = 0; s2 < 2; ++s2) { const u32x4 a = B[SC_KF + (rd * 2 + s2) * 64 + lane]; S[rd][0] = mfma16(a, Vb[s2][0], S[rd][0]); S[rd][1] = mfma16(a, Vb[s2][1], S[rd][1]); } }
#pragma unroll
            for (int s = 0; s < 4; ++s)
#pragma unroll
                for (int nb = 0; nb < 2; ++nb) Sbf[s][nb] = (u32x4){pack2(S[2 * s][nb][0], S[2 * s][nb][1]), pack2(S[2 * s][nb][2], S[2 * s][nb][3]), pack2(S[2 * s + 1][nb][0], S[2 * s + 1][nb][1]), pack2(S[2 * s + 1][nb][2], S[2 * s + 1][nb][3])};
#pragma unroll
            for (int nb = 0; nb < 2; ++nb)
#pragma unroll
                for (int r = 0; r < 4; ++r) OR[(size_t)(cb + n) * 2048 + ((2 * w + nb) * 4 + r) * 64 + lane] = (u32x2){pack2(o[r][nb][0], o[r][nb][1]), pack2(o[r][nb][2], o[r][nb][3])};
            lds_barrier();
        }
    }
}
__device__ __forceinline__ void phase_gdn_norm(const Params& p, LAS unsigned char* lds) {
    const u32x2* OR = (const u32x2*)(p.ws + WS_ORAW); const bf16_t* z = (const bf16_t*)(p.ws + WS_Z); bf16_t* oa = (bf16_t*)(p.ws + WS_OA); const float* nw = p.in[7];
    const int lane = threadIdx.x & 63, w = threadIdx.x >> 6, m = lane & 15, q = lane >> 4, gw = blockIdx.x * 8 + w, nwv_ = gridDim.x * 8;
    LAS bf16_t* tile = (LAS bf16_t*)lds + w * (16 * QROW);
    const int tl = lane >> 2, eq = lane & 3;
    float nwv[32];
#pragma unroll
    for (int i = 0; i < 32; ++i) nwv[i] = nw[32 * eq + i];
    for (int it = gw; it < 4096 * 4; it += nwv_) {
        const int chunk = it >> 2, r = it & 3; const int b = chunk >> 11, h = (chunk >> 8) & 7, n = chunk & 255;
        const size_t off = ((size_t)b * SEQ + n * 64 + 16 * r + tl) * 1024 + h * 128 + 32 * eq;
        u32x4 zz[4];
#pragma unroll
        for (int i = 0; i < 4; ++i) zz[i] = *(const u32x4*)(z + off + 8 * i);
#pragma unroll
        for (int eb = 0; eb < 8; ++eb) { const u32x2 u = OR[(size_t)chunk * 2048 + (eb * 4 + r) * 64 + lane]; LAS bf16_t* tp = tile + (4 * q) * QROW + 16 * eb + m;
            tp[0] = (bf16_t)(u.x & 0xffffu); tp[QROW] = (bf16_t)(u.x >> 16); tp[2 * QROW] = (bf16_t)(u.y & 0xffffu); tp[3 * QROW] = (bf16_t)(u.y >> 16); }
        asm volatile("s_waitcnt lgkmcnt(0)" ::: "memory");
        u32x4 oo[4];
#pragma unroll
        for (int i = 0; i < 4; ++i) oo[i] = *(const LAS u32x4*)(tile + tl * QROW + 32 * eq + 8 * i);
        float ov[32]; float ss = 0.f;
#pragma unroll
        for (int i = 0; i < 4; ++i) { ov[8 * i] = bflo(oo[i].x); ov[8 * i + 1] = bfhi(oo[i].x); ov[8 * i + 2] = bflo(oo[i].y); ov[8 * i + 3] = bfhi(oo[i].y); ov[8 * i + 4] = bflo(oo[i].z); ov[8 * i + 5] = bfhi(oo[i].z); ov[8 * i + 6] = bflo(oo[i].w); ov[8 * i + 7] = bfhi(oo[i].w); }
#pragma unroll
        for (int i = 0; i < 32; ++i) ss += ov[i] * ov[i];
        ss += __shfl_xor(ss, 1); ss += __shfl_xor(ss, 2); const float rs = __builtin_amdgcn_rsqf(ss * (1.0f / 128.0f) + EPS);
#pragma unroll
        for (int i = 0; i < 4; ++i) { const unsigned zw[4] = {zz[i].x, zz[i].y, zz[i].z, zz[i].w}; unsigned ow[4];
#pragma unroll
            for (int k = 0; k < 4; ++k) ow[k] = pack2(ov[8 * i + 2 * k] * rs * nwv[8 * i + 2 * k] * siluf_(bflo(zw[k])), ov[8 * i + 2 * k + 1] * rs * nwv[8 * i + 2 * k + 1] * siluf_(bfhi(zw[k])));
            *(u32x4*)(oa + off + 8 * i) = (u32x4){ow[0], ow[1], ow[2], ow[3]}; }
        asm volatile("s_waitcnt lgkmcnt(0)" ::: "memory");
    }
    lds_barrier();
}
constexpr int NPHASE = 10;
__global__ void __launch_bounds__(NTHREADS, 2) mega(Params p) {
    extern __shared__ __attribute__((aligned(16))) unsigned char lds_raw[];
    LAS unsigned char* lds = (LAS unsigned char*)lds_raw;
    cg::grid_group grid = cg::this_grid();
    unsigned char* ws = p.ws;
    const int lo = p.ph_lo, hi = p.ph_hi;
    const int G = (int)gridDim.x, bx = (int)blockIdx.x;
#define IN(k) (lo <= (k) && (k) < hi)
#define SEAM(k) do { if (IN(k) && IN((k) + 1)) grid.sync(); } while (0)
    if (IN(0)) { phase_prep(p, lds); } SEAM(0);
    if (IN(1)) { EpiIn E{(bf16_t*)(ws + WS_GRAW), (bf16_t*)(ws + WS_Z), (bf16_t*)(ws + WS_SQKV), (bf16_t*)p.out, (float*)(ws + WS_AB), 0};
        run_gemm_sub(lds, (const bf16_t*)(ws + WS_H), (const bf16_t*)(ws + WS_WT_IN), T, 3072, DM, E, G, bx); } SEAM(1);
    if (IN(2)) { PrepRaw R;
        if (bx < 512) gdn_prep_load(p, ((bx >> 8) * 8) * 256 + (bx & 255), R);
        for (int tb = bx; tb < 512; tb += G) { const int b = tb >> 8, n = tb & 255;
            gdn_ab_block(p, lds, b * SEQ + n * 64);
            for (int h = 0; h < 8; ++h) { const int chunk = (b * 8 + h) * 256 + n;
                int nxt = 4096; if (h < 7) nxt = chunk + 256; else if (tb + G < 512) { const int t2 = tb + G; nxt = ((t2 >> 8) * 8) * 256 + (t2 & 255); }
                gdn_prep_chunk(p, lds, chunk, R, nxt); } } } SEAM(2);
    if (IN(3)) { const int ns = G > 32 ? 16 : 0;
        if (bx < ns || ns == 0) { for (int bh = bx; bh < 16; bh += (ns ? ns : G)) gdn_scan(p, lds, bh); }
        if (bx >= ns) {
            { EpiIn E{(bf16_t*)(ws + WS_GRAW), (bf16_t*)(ws + WS_Z), (bf16_t*)(ws + WS_SQKV), nullptr, (float*)(ws + WS_AB), 13};
              run_gemm_sub(lds, (const bf16_t*)(ws + WS_H), (const bf16_t*)(ws + WS_WT_IN) + (size_t)IN_A_ROWS * DM, T, 4 * 256, DM, E, G - ns, bx - ns); }
            { EpiVG8 E{(bf16_t*)(ws + WS_SQKV), (unsigned char*)p.out + OUT_G8};
              run_gemm_f8(lds, (const unsigned char*)p.out + OUT_H8, ws + WS_WG8, T, 8704, DM, E, G - ns, (bx - ns + (G - ns) / 2) % (G - ns)); } } } SEAM(3);
    if (IN(4)) { phase_gdn_norm(p, lds); phase_swa_attn(p, lds); } SEAM(4);
    if (IN(5)) { phase_swa_combine(p); } SEAM(5);
    if (IN(6)) { { EpiMix E{(const unsigned char*)p.out + OUT_G8, 0, (bf16_t*)(ws + WS_MIXED), 1}; run_gemm_sub(lds, (const bf16_t*)(ws + WS_OA), (const bf16_t*)(ws + WS_WT_GDN), T, DM, 1024, E, G, bx); }
                 { EpiMix E{(const unsigned char*)p.out + OUT_G8, 2048, (bf16_t*)(ws + WS_MIXED), 0}; run_gemm_sub(lds, (const bf16_t*)(ws + WS_OB), (const bf16_t*)(ws + WS_WT_SWA), T, DM, 512, E, G, bx); } } SEAM(6);
    if (IN(7)) { EpiOut E{p.in[0], p.out, (bf16_t*)(ws + WS_X1B), (float*)(ws + WS_ROWSS)}; run_gemm_sub(lds, (const bf16_t*)(ws + WS_MIXED), (const bf16_t*)(ws + WS_WT_OUT), T, DM, DM, E, G, bx); } SEAM(7);
    if (IN(8)) { EpiRelu2 E{(bf16_t*)(ws + WS_U), (const float*)(ws + WS_ROWSS)}; run_gemm_sub(lds, (const bf16_t*)(ws + WS_X1B), (const bf16_t*)(ws + WS_WT_FF1), T, DFF, DM, E, G, bx); } SEAM(8);
    if (IN(9)) { EpiResB E{(const bf16_t*)(ws + WS_X1B), p.out}; run_gemm_sub(lds, (const bf16_t*)(ws + WS_U), (const bf16_t*)(ws + WS_WT_FF2), T, DM, DFF, E, G, bx); }
#undef IN
#undef SEAM
}

#ifndef ONE_LAUNCH
#define ONE_LAUNCH 1
#endif
extern "C" void kernel_launch(void* const* d_in, const int* in_sizes, int n_in, void* d_out, int out_size, void* d_ws, size_t ws_size, hipStream_t stream) {
    if (n_in != 16 || ws_size < WS_END || out_size != T * DM) { fprintf(stderr, "kernel_launch: unexpected shapes (n_in %d ws %zu out %d)\n", n_in, ws_size, out_size); return; }
    static int grid = 0;
    if (grid == 0) { int dev = 0, cus = 0; (void)hipGetDevice(&dev); (void)hipDeviceGetAttribute(&cus, hipDeviceAttributeMultiprocessorCount, dev); grid = cus > 0 ? cus : 256; }
    (void)hipFuncSetAttribute((const void*)mega, hipFuncAttributeMaxDynamicSharedMemorySize, LDS_BYTES);
    Params p{};
    for (int i = 0; i < 16; ++i) p.in[i] = (const float*)d_in[i];
    p.out = (float*)d_out; p.ws = (unsigned char*)d_ws;
#if ONE_LAUNCH
    p.ph_lo = 0; p.ph_hi = NPHASE;
    void* args[] = {&p};
    hipError_t e = hipLaunchCooperativeKernel((const void*)mega, dim3(grid), dim3(NTHREADS), args, LDS_BYTES, stream);
    if (e != hipSuccess) fprintf(stderr, "cooperative launch failed: %s (grid %d)\n", hipGetErrorString(e), grid);
#else
    for (int ph = 0; ph < NPHASE; ++ph) { p.ph_lo = ph; p.ph_hi = ph + 1; hipLaunchKernelGGL(mega, dim3(grid), dim3(NTHREADS), LDS_BYTES, stream, p); }
#endif
}
```

```cpp
#include <hip/hip_runtime.h>
#include <hip/hip_cooperative_groups.h>
#include <cstdio>
namespace cg = cooperative_groups;
namespace pg8 {
#define PG8_LAS __attribute__((address_space(3)))
typedef unsigned short bf16_t;
typedef short bf16x8 __attribute__((ext_vector_type(8)));
typedef float f32x4 __attribute__((ext_vector_type(4)));
typedef unsigned u32x4 __attribute__((ext_vector_type(4)));
constexpr int BM = 256, BK = 64, HALF = 128, HTB = HALF * BK * 2  , STAGE_BYTES = 8 * HTB, NXCD = 8, WGM = 8;

__host__ __device__ __forceinline__ int lds_byte(int r, int c) { const int st = (r >> 4) * 2 + (c >> 5), rr = r & 15, cc = c & 31, ob = rr * 64 + cc * 2; return st * 1024 + (ob ^ (((ob >> 9) & 1) << 5)); }
__host__ __device__ __forceinline__ void stage_rc(int b, int& R, int& C) { const int st = b / 1024, sb = b % 1024, swz = sb ^ (((sb >> 9) & 1) << 5); R = (st >> 1) * 16 + swz / 64; C = (st & 1) * 32 + (swz % 64) / 2; }
__host__ __device__ __forceinline__ int perm32(int rho) { const int n = rho >> 4, i = rho & 15; return 8 * (i >> 2) + 4 * n + (i & 3); }

struct Unit { int pm, pn; };
struct Gemm { const bf16_t* A; const bf16_t* Bt; int M, N, K; };

struct StaticOrder {
    int nM, nN, nwg, G, c;
    __host__ __device__ void init(int M, int N, int G_, int c_) { nM = M / BM; nN = N / BM; nwg = nM * nN; G = G_; c = c_; }
    __host__ __device__ bool next(int i, Unit& u) const {
        const long L = (long)i * G + c; if (L >= nwg) return false;
        int wgid = (int)L; { const int q = nwg / NXCD, r = nwg % NXCD, xcd = wgid % NXCD, off = wgid / NXCD; wgid = (xcd < r ? xcd * (q + 1) : r * (q + 1) + (xcd - r) * q) + off; }
        const int nig = WGM * nN, gid = wgid / nig, fm = gid * WGM, gsz = (nM - fm) < WGM ? (nM - fm) : WGM;
        u.pm = fm + ((wgid % nig) % gsz); u.pn = (wgid % nig) / gsz; return true;
    }
    __device__ __forceinline__ void a_ready(const Unit&) const {}
    __device__ __forceinline__ void done(const Unit&) const {}
};
__device__ __forceinline__ unsigned cvt_pk_bf16(float lo, float hi) { unsigned r; asm volatile("v_cvt_pk_bf16_f32 %0, %1, %2" : "=v"(r) : "v"(lo), "v"(hi)); return r; }
typedef float f32x2 __attribute__((ext_vector_type(2)));
typedef int i32x8 __attribute__((ext_vector_type(8)));
typedef int i32x4v __attribute__((ext_vector_type(4)));
__device__ __forceinline__ void mfma_f8_acc(f32x4& c, const i32x8& b, const i32x8& a) { asm volatile("v_mfma_f32_16x16x128_f8f6f4 %0, %1, %2, %0" : "+v"(c) : "v"(b), "v"(a)); }
template <class Epi, class Sched, bool STAMP = false, bool F8 = false>
__device__ __forceinline__ void gemm_phase(PG8_LAS unsigned char* lds, const Gemm g, const Sched& S, const Epi& E, unsigned long long* stamps) {
    const int tid = threadIdx.x, wid = __builtin_amdgcn_readfirstlane(tid >> 6), lane = tid & 63, wr = wid >> 2, wc = wid & 3, fr = lane & 15, fq = lane >> 4;
    const int K = g.K, nt = K / BK;
    int ts_lo = 0, ts_hi = 0, nts = 0; const unsigned long long rt_entry = STAMP ? (unsigned long long)wall_clock64() : 0ull;
#define PG8_STAMP() do { if (STAMP && wid == 0 && nts < 64) { const unsigned long long _c = (unsigned long long)clock64(); \
        ts_lo = (lane == nts) ? (int)(unsigned)_c : ts_lo; ts_hi = (lane == nts) ? (int)(unsigned)(_c >> 32) : ts_hi; ++nts; } } while (0)
    PG8_STAMP();
    unsigned voffA[2], voffB[2];
#pragma unroll
    for (int i = 0; i < 2; ++i) { int R, C; stage_rc(tid * 16 + i * 8192, R, C); const int Rb = Epi::PERM ? ((R & ~31) + perm32(R & 31)) : R;
        voffA[i] = (unsigned)(R * K + C) * 2u; voffB[i] = (unsigned)(Rb * K + C) * 2u; }
    const size_t kstep = (size_t)(BK * 2);
    const size_t hstep = (size_t)HALF * K * 2;
    const size_t tstep = 2 * hstep;
    const unsigned ldsw = (unsigned)wid * 1024u;
    const int aoff = lds_byte(wr * 64 + fr, fq * 8), boff = lds_byte(wc * 32 + fr, fq * 8);
#define PG8_SA(b, h) (((b) * 2 + (h)) * HTB)
#define PG8_SB(b, h) ((4 + (b) * 2 + (h)) * HTB)
#define PG8_STAGE(bufoff, gbase, voff) do { _Pragma("unroll") for (int _i = 0; _i < 2; ++_i) \
        __builtin_amdgcn_global_load_lds((const unsigned*)((const char*)(gbase) + (voff)[_i]), (PG8_LAS unsigned*)(lds + (bufoff) + ldsw + _i * 8192), 16, 0, 0); } while (0)
#define PG8_LDA(dst, b, h) do { if constexpr (F8) { _Pragma("unroll") for (int m = 0; m < 4; ++m) { const i32x4v lo_ = *(const PG8_LAS i32x4v*)(lds + PG8_SA(b, h) + aoff + m * 2048), hi_ = *(const PG8_LAS i32x4v*)(lds + PG8_SA(b, h) + aoff + m * 2048 + 1024); dst##8[m] = __builtin_shufflevector(lo_, hi_, 0, 1, 2, 3, 4, 5, 6, 7); } } \
        else { _Pragma("unroll") for (int m = 0; m < 4; ++m) _Pragma("unroll") for (int k = 0; k < 2; ++k) dst[m][k] = *(const PG8_LAS bf16x8*)(lds + PG8_SA(b, h) + aoff + m * 2048 + k * 1024); } } while (0)
#define PG8_LDB(dst, b, h) do { if constexpr (F8) { _Pragma("unroll") for (int n = 0; n < 2; ++n) { const i32x4v lo_ = *(const PG8_LAS i32x4v*)(lds + PG8_SB(b, h) + boff + n * 2048), hi_ = *(const PG8_LAS i32x4v*)(lds + PG8_SB(b, h) + boff + n * 2048 + 1024); dst##8[n] = __builtin_shufflevector(lo_, hi_, 0, 1, 2, 3, 4, 5, 6, 7); } } \
        else { _Pragma("unroll") for (int n = 0; n < 2; ++n) _Pragma("unroll") for (int k = 0; k < 2; ++k) dst[n][k] = *(const PG8_LAS bf16x8*)(lds + PG8_SB(b, h) + boff + n * 2048 + k * 1024); } } while (0)
#define PG8_MMA(ai, bj, At, Bt) do { __builtin_amdgcn_s_setprio(1); _Pragma("unroll") for (int m = 0; m < 4; ++m) _Pragma("unroll") for (int n = 0; n < 2; ++n) { \
        if constexpr (F8) mfma_f8_acc(acc[ai][bj][m][n], Bt##8[n], At##8[m]); \
        else { _Pragma("unroll") for (int k = 0; k < 2; ++k) acc[ai][bj][m][n] = __builtin_amdgcn_mfma_f32_16x16x32_bf16(Bt[n][k], At[m][k], acc[ai][bj][m][n], 0, 0, 0); } } __builtin_amdgcn_s_setprio(0); } while (0)
#define PG8_WAIT_V(n) asm volatile("s_waitcnt vmcnt(" #n ")" ::: "memory")
#define PG8_WAIT_L(n) asm volatile("s_waitcnt lgkmcnt(" #n ")" ::: "memory")
#define PG8_BAR __builtin_amdgcn_s_barrier()
#define PG8_SCHED __builtin_amdgcn_sched_barrier(0)
    Unit cur, nxt; int ui = 0;
    if (!S.next(0, cur)) return;
    f32x4 acc[2][2][4][2];
#pragma unroll
    for (int a = 0; a < 2; ++a)
#pragma unroll
        for (int b = 0; b < 2; ++b)
#pragma unroll
            for (int m = 0; m < 4; ++m)
#pragma unroll
                for (int n = 0; n < 2; ++n) acc[a][b][m][n] = (f32x4){0.f, 0.f, 0.f, 0.f};
    bf16x8 At[4][2], B0[2][2], B1[2][2]; i32x8 At8[4], B08[2], B18[2];
    const char* cA = (const char*)g.A + (size_t)cur.pm * tstep; const char* cB = (const char*)g.Bt + (size_t)cur.pn * tstep;
    S.a_ready(cur);
    PG8_STAGE(PG8_SB(0, 0), cB, voffB); PG8_STAGE(PG8_SA(0, 0), cA, voffA); PG8_STAGE(PG8_SB(0, 1), cB + hstep, voffB); PG8_STAGE(PG8_SA(0, 1), cA + hstep, voffA);
    if (wr == 1) PG8_BAR;
    PG8_WAIT_V(4); PG8_BAR;
    PG8_STAGE(PG8_SB(1, 0), cB + kstep, voffB); PG8_STAGE(PG8_SA(1, 0), cA + kstep, voffA); PG8_STAGE(PG8_SB(1, 1), cB + hstep + kstep, voffB);
    PG8_WAIT_V(6); PG8_BAR;
    PG8_STAMP();
    for (;;) {
        const bool has_next = S.next(ui + 1, nxt);
        const char* nA = has_next ? (const char*)g.A + (size_t)nxt.pm * tstep : cA; const char* nB = has_next ? (const char*)g.Bt + (size_t)nxt.pn * tstep : cB;
        for (int t = 0; t < nt; t += 2) {
            const bool last = (t == nt - 2);
            const char* a1 = cA + (size_t)(t + 1) * kstep;
            const char* a2 = last ? nA : cA + (size_t)(t + 2) * kstep; const char* b2 = last ? nB : cB + (size_t)(t + 2) * kstep;
            const char* a3 = a2 + kstep; const char* b3 = b2 + kstep;
            if (last && has_next) S.a_ready(nxt);
            PG8_LDB(B0, 0, 0); PG8_SCHED; PG8_LDA(At, 0, 0); PG8_STAGE(PG8_SA(1, 1), a1 + hstep, voffA);
            PG8_WAIT_L(8); PG8_BAR; PG8_WAIT_L(0); PG8_MMA(0, 0, At, B0); PG8_BAR; PG8_SCHED;
            PG8_LDB(B1, 0, 1); PG8_STAGE(PG8_SB(0, 0), b2, voffB);
            PG8_BAR; PG8_WAIT_L(0); PG8_MMA(0, 1, At, B1); PG8_BAR;
            PG8_LDA(At, 0, 1); PG8_STAGE(PG8_SA(0, 0), a2, voffA);
            PG8_BAR; PG8_WAIT_L(0); PG8_MMA(1, 0, At, B0); PG8_BAR; PG8_SCHED;
            PG8_STAGE(PG8_SB(0, 1), b2 + hstep, voffB);
            PG8_WAIT_V(6); PG8_BAR; PG8_MMA(1, 1, At, B1); PG8_BAR;
            PG8_LDB(B0, 1, 0); PG8_SCHED; PG8_LDA(At, 1, 0); PG8_STAGE(PG8_SA(0, 1), a2 + hstep, voffA);
            PG8_WAIT_L(8); PG8_BAR; PG8_WAIT_L(0); PG8_MMA(0, 0, At, B0); PG8_BAR; PG8_SCHED;
            PG8_LDB(B1, 1, 1); PG8_STAGE(PG8_SB(1, 0), b3, voffB);
            PG8_BAR; PG8_WAIT_L(0); PG8_MMA(0, 1, At, B1); PG8_BAR;
            PG8_LDA(At, 1, 1); PG8_STAGE(PG8_SA(1, 0), a3, voffA);
            PG8_BAR; PG8_WAIT_L(0); PG8_MMA(1, 0, At, B0); PG8_BAR; PG8_SCHED;
            PG8_STAGE(PG8_SB(1, 1), b3 + hstep, voffB);
            PG8_WAIT_V(6); PG8_BAR; PG8_MMA(1, 1, At, B1); PG8_BAR;
        }
        PG8_STAMP();
        if constexpr (F8) {
            asm volatile("s_nop 15\n\ts_nop 15" : "+v"(acc[0][0][0][0]), "+v"(acc[0][0][0][1]), "+v"(acc[0][0][1][0]), "+v"(acc[0][0][1][1]), "+v"(acc[0][0][2][0]), "+v"(acc[0][0][2][1]), "+v"(acc[0][0][3][0]), "+v"(acc[0][0][3][1]), "+v"(acc[0][1][0][0]), "+v"(acc[0][1][0][1]), "+v"(acc[0][1][1][0]), "+v"(acc[0][1][1][1]), "+v"(acc[0][1][2][0]), "+v"(acc[0][1][2][1]), "+v"(acc[0][1][3][0]), "+v"(acc[0][1][3][1]));
            asm volatile("s_nop 15\n\ts_nop 15" : "+v"(acc[1][0][0][0]), "+v"(acc[1][0][0][1]), "+v"(acc[1][0][1][0]), "+v"(acc[1][0][1][1]), "+v"(acc[1][0][2][0]), "+v"(acc[1][0][2][1]), "+v"(acc[1][0][3][0]), "+v"(acc[1][0][3][1]), "+v"(acc[1][1][0][0]), "+v"(acc[1][1][0][1]), "+v"(acc[1][1][1][0]), "+v"(acc[1][1][1][1]), "+v"(acc[1][1][2][0]), "+v"(acc[1][1][2][1]), "+v"(acc[1][1][3][0]), "+v"(acc[1][1][3][1])); }
        if constexpr (!Epi::AFTER_DRAIN) { E(acc, cur, wr, wc, fr, fq); S.done(cur); }
        PG8_STAMP();
        if (!has_next) break;
#pragma unroll
        for (int a = 0; a < 2; ++a)
#pragma unroll
            for (int b = 0; b < 2; ++b)
#pragma unroll
                for (int m = 0; m < 4; ++m)
#pragma unroll
                    for (int n = 0; n < 2; ++n) acc[a][b][m][n] = (f32x4){0.f, 0.f, 0.f, 0.f};
        cur = nxt; cA = nA; cB = nB; ++ui;
    }
    PG8_WAIT_V(0);
    if (wr == 0) PG8_BAR;
    PG8_BAR;
    if constexpr (Epi::AFTER_DRAIN) { E.fused(acc, cur, wr, wc, fr, fq, lds, wid, lane); S.done(cur); }
    PG8_STAMP();
    if (STAMP && wid == 0) { stamps[lane] = lane < nts ? (((unsigned long long)(unsigned)ts_hi << 32) | (unsigned)ts_lo) : 0ull;
        if (lane == 62) stamps[62] = rt_entry; if (lane == 63) stamps[63] = (unsigned long long)wall_clock64(); }
#undef PG8_STAMP
#undef PG8_SA
#undef PG8_SB
#undef PG8_STAGE
#undef PG8_LDA
#undef PG8_LDB
#undef PG8_MMA
#undef PG8_WAIT_V
#undef PG8_WAIT_L
#undef PG8_BAR
#undef PG8_SCHED
}
}

typedef unsigned short bf16_t;
typedef unsigned u32x4 __attribute__((ext_vector_type(4)));
typedef unsigned u32x2 __attribute__((ext_vector_type(2)));
typedef float f32x4 __attribute__((ext_vector_type(4)));
typedef float f32x2 __attribute__((ext_vector_type(2)));
#define LAS __attribute__((address_space(3)))

constexpr int SEQ = 16384, NB = 2, T = NB * SEQ, DM = 2048, DFF = 8192;
constexpr int IN_COLS = 12816, IN_PAD = 13056;
constexpr float EPS = 1e-6f;
constexpr size_t MiB = 1u << 20;
constexpr size_t WS_WT_FF1 = 0, WS_WT_FF2 = 32 * MiB, WS_WT_OUT = 64 * MiB, WS_WT_GDN = 72 * MiB, WS_WT_SWA = 76 * MiB, WS_WT_IN = 78 * MiB,
                 WS_H = 129 * MiB, WS_WF = 257 * MiB, WS_QF = 321 * MiB, WS_KF = 385 * MiB, WS_AF = 449 * MiB, WS_UACC = 481 * MiB,
                 WS_GRAW = 545 * MiB, WS_Z = 545 * MiB, WS_ORAW = 609 * MiB, WS_SQKV = 673 * MiB, WS_GDEC = 961 * MiB, WS_CTR = 962 * MiB, WS_ROWSS = 963 * MiB, WS_ROPE = 964 * MiB,
                 WS_OG = 129 * MiB, WS_LSE = 225 * MiB, WS_OA = 257 * MiB, WS_OB = 321 * MiB, WS_MIXED = 385 * MiB,
                 WS_X1B = 129 * MiB, WS_U = 257 * MiB, WS_AB = 1022 * MiB, WS_END = 1024 * MiB;
constexpr size_t OUT_G8 = 0, OUT_H8 = 128 * MiB;
constexpr size_t WS_WG8 = WS_WT_IN + (size_t)4352 * 2048 * 2;
constexpr int IN_A_ROWS = 3328;
constexpr int LDS_BYTES = 144 * 1024;
constexpr int NTHREADS = 512;

static __device__ const double ROPE_REV[64] = {
1.59154943091895346e-01, 1.37822502603982849e-01, 1.19349370211248862e-01, 1.03352296618434064e-01,
8.94994016088910133e-02, 7.75032887553740585e-02, 6.71150830052272551e-02, 5.81192674418762462e-02,
5.03292121044870353e-02, 4.35833021053073297e-02, 3.77415847174197711e-02, 3.26828658723569976e-02,
2.83021958306233987e-02, 2.45086918620698521e-02, 2.12236527647776604e-02, 1.83789261056796667e-02,
1.59154943091895339e-02, 1.37822502603982839e-02, 1.19349370211248862e-02, 1.03352296618434061e-02,
8.94994016088910237e-03, 7.75032887553740550e-03, 6.71150830052272534e-03, 5.81192674418762410e-03,
5.03292121044870370e-03, 4.35833021053073314e-03, 3.77415847174197719e-03, 3.26828658723569932e-03,
2.83021958306233987e-03, 2.45086918620698521e-03, 2.12236527647776622e-03, 1.83789261056796667e-03,
1.59154943091895356e-03, 1.37822502603982878e-03, 1.19349370211248849e-03, 1.03352296618434048e-03,
8.94994016088910237e-04, 7.75032887553740507e-04, 6.71150830052272599e-04, 5.81192674418762388e-04,
5.03292121044870326e-04, 4.35833021053073292e-04, 3.77415847174197741e-04, 3.26828658723569922e-04,
2.83021958306233954e-04, 2.45086918620698543e-04, 2.12236527647776605e-04, 1.83789261056796662e-04,
1.59154943091895351e-04, 1.37822502603982856e-04, 1.19349370211248862e-04, 1.03352296618434061e-04,
8.94994016088910182e-05, 7.75032887553740561e-05, 6.71150830052272545e-05, 5.81192674418762388e-05,
5.03292121044870354e-05, 4.35833021053073225e-05, 3.77415847174197768e-05, 3.26828658723569989e-05,
2.83021958306233961e-05, 2.45086918620698523e-05, 2.12236527647776592e-05, 1.83789261056796682e-05

};

typedef __bf16 hwbf16x2 __attribute__((ext_vector_type(2)));
__device__ __forceinline__ unsigned pack2(float lo, float hi) { const f32x2 v = {lo, hi}; return __builtin_bit_cast(unsigned, __builtin_convertvector(v, hwbf16x2)); }
__device__ __forceinline__ unsigned short f2bf(float f) { return (unsigned short)(pack2(f, 0.f) & 0xffffu); }
__device__ __forceinline__ float bflo(unsigned w) { return __uint_as_float(w << 16); }
__device__ __forceinline__ float bfhi(unsigned w) { return __uint_as_float(w & 0xffff0000u); }
__device__ __forceinline__ float sigmoidf_(float x) { return __builtin_amdgcn_rcpf(1.0f + __expf(-x)); }
__device__ __forceinline__ float siluf_(float x) { return x * __builtin_amdgcn_rcpf(1.0f + __expf(-x)); }
template <int CTRL> __device__ __forceinline__ float dpp_f(float v) { return __builtin_bit_cast(float, __builtin_amdgcn_update_dpp(0, __builtin_bit_cast(int, v), CTRL, 0xF, 0xF, false)); }
__device__ __forceinline__ float wave_sum(float v) {
    v += dpp_f<0xB1>(v); v += dpp_f<0x4E>(v); v += dpp_f<0x124>(v); v += dpp_f<0x128>(v);
    const int iv = __builtin_bit_cast(int, v);
    const float r0 = __builtin_bit_cast(float, __builtin_amdgcn_readlane(iv, 0)), r1 = __builtin_bit_cast(float, __builtin_amdgcn_readlane(iv, 16)), r2 = __builtin_bit_cast(float, __builtin_amdgcn_readlane(iv, 32)), r3 = __builtin_bit_cast(float, __builtin_amdgcn_readlane(iv, 48));
    return (r0 + r1) + (r2 + r3);
}

__device__ __forceinline__ void lds_barrier() { asm volatile("s_waitcnt lgkmcnt(0)" ::: "memory"); __builtin_amdgcn_s_barrier(); asm volatile("" ::: "memory"); }
typedef short bf16x8 __attribute__((ext_vector_type(8)));
__device__ __forceinline__ f32x4 mfma16(u32x4 a, u32x4 b, f32x4 c) { return __builtin_amdgcn_mfma_f32_16x16x32_bf16(__builtin_bit_cast(bf16x8, a), __builtin_bit_cast(bf16x8, b), c, 0, 0, 0); }
struct Params { const float* in[16]; float* out; unsigned char* ws; int ph_lo, ph_hi; };

struct WtTask { const float* src; const float* scale; bf16_t* dst; int K, N, kt, nt, mode; };
__device__ __forceinline__ WtTask wt_task(const Params& p, int t) {
    unsigned char* ws = p.ws;
    const int c0 = 16 * 201, c1 = c0 + 16 * 128, c2 = c1 + 64 * 32, c3 = c2 + 16 * 32, c4 = c3 + 8 * 32;
    if (t < c0) return WtTask{p.in[3], nullptr, (bf16_t*)(ws + WS_WT_IN), DM, IN_COLS, t / 201, t % 201, 1};
    if (t < c1) { const int u = t - c0; return WtTask{p.in[14], p.in[13], (bf16_t*)(ws + WS_WT_FF1), DM, DFF, u / 128, u % 128, 0}; }
    if (t < c2) { const int u = t - c1; return WtTask{p.in[15], nullptr, (bf16_t*)(ws + WS_WT_FF2), DFF, DM, u / 32, u % 32, 0}; }
    if (t < c3) { const int u = t - c2; return WtTask{p.in[12], nullptr, (bf16_t*)(ws + WS_WT_OUT), DM, DM, u / 32, u % 32, 0}; }
    if (t < c4) { const int u = t - c3; return WtTask{p.in[8], nullptr, (bf16_t*)(ws + WS_WT_GDN), 1024, DM, u / 32, u % 32, 0}; }
    const int u = t - c4; return WtTask{p.in[11], nullptr, (bf16_t*)(ws + WS_WT_SWA), 512, DM, u / 32, u % 32, 0};
}
__device__ __forceinline__ void wt_load(const WtTask& k, float (&v)[16]) {
    const int tid = threadIdx.x, k0 = k.kt * 128, n = k.nt * 64 + (tid & 63);
#pragma unroll
    for (int r = 0; r < 16; ++r) { const int i = (tid >> 6) + 8 * r; float x = 0.f; if (n < k.N) x = k.src[(size_t)(k0 + i) * k.N + n]; if (k.scale) x *= k.scale[k0 + i]; v[r] = x; }
}
__device__ __forceinline__ void wt_all(const Params& p, LAS float* lds_tiles) {
    const int ntask = 16 * 201 + 16 * 128 + 64 * 32 + 16 * 32 + 8 * 32 + 4 * 32;
    const int tid = threadIdx.x; int t = blockIdx.x, it = 0; if (t >= ntask) return;
    WtTask cur = wt_task(p, t); float v[16]; wt_load(cur, v);
    for (;;) {
        LAS float* tile = lds_tiles + (it & 1) * (128 * 65);
#pragma unroll
        for (int r = 0; r < 16; ++r) tile[((tid >> 6) + 8 * r) * 65 + (tid & 63)] = v[r];
        lds_barrier();
        const int tn = t + gridDim.x; const bool more = tn < ntask; WtTask nxt = cur;
        if (more) { nxt = wt_task(p, tn); wt_load(nxt, v); }
        { const int j = tid >> 3, ic = tid & 7, n = cur.nt * 64 + j;
          if (n < cur.N && cur.mode && n >= 4112) {
              unsigned qq[4];
#pragma unroll
              for (int g4 = 0; g4 < 4; ++g4) { const int kb = ic * 16 + g4 * 4; unsigned q8 = __builtin_amdgcn_cvt_pk_fp8_f32(tile[(kb + 0) * 65 + j] * 64.f, tile[(kb + 1) * 65 + j] * 64.f, 0, false);
                  q8 = __builtin_amdgcn_cvt_pk_fp8_f32(tile[(kb + 2) * 65 + j] * 64.f, tile[(kb + 3) * 65 + j] * 64.f, q8, true); qq[g4] = q8; }
              *(u32x4*)(p.ws + WS_WG8 + (size_t)(n - 4112) * 2048 + cur.kt * 128 + ic * 16) = (u32x4){qq[0], qq[1], qq[2], qq[3]};
          } else
          if (n < cur.N) { const int drow = cur.mode ? (n < 3072 ? n : (n < 4096 ? n + 256 : (n < 4112 ? n - 1024 : n + 240))) : n;
              bf16_t* dp = cur.dst + (size_t)drow * cur.K + cur.kt * 128 + ic * 16;
#pragma unroll
              for (int hh = 0; hh < 2; ++hh) { const int kb = ic * 16 + hh * 8; u32x4 w;
                  w.x = pack2(tile[(kb + 0) * 65 + j], tile[(kb + 1) * 65 + j]); w.y = pack2(tile[(kb + 2) * 65 + j], tile[(kb + 3) * 65 + j]);
                  w.z = pack2(tile[(kb + 4) * 65 + j], tile[(kb + 5) * 65 + j]); w.w = pack2(tile[(kb + 6) * 65 + j], tile[(kb + 7) * 65 + j]);
                  *(u32x4*)(dp + hh * 8) = w; } } }
        if (!more) break;
        cur = nxt; t = tn; ++it;
    }
    lds_barrier();
}
__device__ __forceinline__ void rms_rows(const float* __restrict__ src, const float* __restrict__ w, bf16_t* __restrict__ dst, unsigned* __restrict__ dst8) {
    const int lane = threadIdx.x & 63, gw = blockIdx.x * 8 + (threadIdx.x >> 6), nw = gridDim.x * 8;
    for (int row = gw; row < T; row += 2 * nw) {
        const int row2 = row + nw; const bool has2 = row2 < T;
        const f32x4* s0 = (const f32x4*)(src + (size_t)row * DM); const f32x4* s1 = (const f32x4*)(src + (size_t)(has2 ? row2 : row) * DM);
        f32x4 v0[8], v1[8]; float ss0 = 0.f, ss1 = 0.f;
#pragma unroll
        for (int i = 0; i < 8; ++i) { v0[i] = s0[lane + 64 * i]; v1[i] = s1[lane + 64 * i]; }
#pragma unroll
        for (int i = 0; i < 8; ++i) { ss0 += v0[i][0] * v0[i][0] + v0[i][1] * v0[i][1] + v0[i][2] * v0[i][2] + v0[i][3] * v0[i][3]; ss1 += v1[i][0] * v1[i][0] + v1[i][1] * v1[i][1] + v1[i][2] * v1[i][2] + v1[i][3] * v1[i][3]; }
        ss0 = wave_sum(ss0); ss1 = wave_sum(ss1);
        const float r0 = __builtin_amdgcn_rsqf(ss0 * (1.0f / DM) + EPS), r1 = __builtin_amdgcn_rsqf(ss1 * (1.0f / DM) + EPS);
#pragma unroll
        for (int i = 0; i < 8; ++i) { const f32x4 ww = ((const f32x4*)w)[lane + 64 * i];
            u32x2 o; o.x = pack2(v0[i][0] * r0 * ww[0], v0[i][1] * r0 * ww[1]); o.y = pack2(v0[i][2] * r0 * ww[2], v0[i][3] * r0 * ww[3]);
            *(u32x2*)(dst + (size_t)row * DM + (lane + 64 * i) * 4) = o;
            { unsigned q8 = __builtin_amdgcn_cvt_pk_fp8_f32(v0[i][0] * r0 * ww[0] * 4.f, v0[i][1] * r0 * ww[1] * 4.f, 0, false); q8 = __builtin_amdgcn_cvt_pk_fp8_f32(v0[i][2] * r0 * ww[2] * 4.f, v0[i][3] * r0 * ww[3] * 4.f, q8, true); dst8[(size_t)row * (DM / 4) + lane + 64 * i] = q8; }
            if (has2) { u32x2 o2; o2.x = pack2(v1[i][0] * r1 * ww[0], v1[i][1] * r1 * ww[1]); o2.y = pack2(v1[i][2] * r1 * ww[2], v1[i][3] * r1 * ww[3]);
                *(u32x2*)(dst + (size_t)row2 * DM + (lane + 64 * i) * 4) = o2;
                unsigned q8 = __builtin_amdgcn_cvt_pk_fp8_f32(v1[i][0] * r1 * ww[0] * 4.f, v1[i][1] * r1 * ww[1] * 4.f, 0, false); q8 = __builtin_amdgcn_cvt_pk_fp8_f32(v1[i][2] * r1 * ww[2] * 4.f, v1[i][3] * r1 * ww[3] * 4.f, q8, true); dst8[(size_t)row2 * (DM / 4) + lane + 64 * i] = q8; } }
    }
}
__device__ __forceinline__ void phase_prep(const Params& p, LAS unsigned char* lds) {
    unsigned char* ws = p.ws; LAS float* tile = (LAS float*)lds;
    wt_all(p, tile);
    const int gt = blockIdx.x * NTHREADS + threadIdx.x, ngt = gridDim.x * NTHREADS;
    { u32x4* z = (u32x4*)((bf16_t*)(ws + WS_WT_IN) + (size_t)3088 * DM); const int n16 = 240 * DM / 8; for (int i = gt; i < n16; i += ngt) z[i] = (u32x4){0u, 0u, 0u, 0u}; }
    if (blockIdx.x == 0 && threadIdx.x < 4) ((unsigned*)(ws + WS_CTR))[threadIdx.x] = 0u;
    { float* rs = (float*)(ws + WS_ROWSS); for (int i = gt; i < T; i += ngt) rs[i] = 0.f; }
    { f32x2* tab = (f32x2*)(ws + WS_ROPE); const int* pos = (const int*)p.in[1];
      for (int i = gt; i < T * 64; i += ngt) { const double a = (double)pos[i >> 6] * ROPE_REV[i & 63]; const float f = (float)(a - floor(a)); tab[i] = (f32x2){__builtin_amdgcn_cosf(f), __builtin_amdgcn_sinf(f)}; } }
    rms_rows(p.in[0], p.in[2], (bf16_t*)(ws + WS_H), (unsigned*)((unsigned char*)p.out + OUT_H8));
}

struct EpiIn {
    static constexpr bool PERM = true, AFTER_DRAIN = false;
    bf16_t* graw; bf16_t* z; bf16_t* sqkv; bf16_t* gates; float* ab; int pn_base;
    __device__ __forceinline__ void operator()(const f32x4 (&acc)[2][2][4][2], const pg8::Unit& u, int wr, int wc, int fr, int fq) const {
        const int row0 = u.pm * 256 + wr * 64 + fr, pn = u.pn + pn_base;
        if (pn == 12) {
            if (wc == 0 && fq < 2) {
#pragma unroll
                for (int ai = 0; ai < 2; ++ai)
#pragma unroll
                    for (int m = 0; m < 4; ++m) { float* d = ab + (size_t)(row0 + ai * 128 + m * 16) * 16 + 8 * fq; *(f32x4*)d = acc[ai][0][m][0]; *(f32x4*)(d + 4) = acc[ai][0][m][1]; }
            }
            return;
        }
        bf16_t* base; int ld, colt; bool sig = false;
        if (pn < 12) { base = graw; ld = 3072; colt = pn * 256; }
        else if (pn < 17) { base = z; ld = 1024; colt = (pn - 13) * 256; }
        else if (pn < 35) { base = sqkv; ld = 4608; colt = (pn - 17) * 256; }
        else { base = gates; ld = 4096; colt = (pn - 35) * 256; sig = true; }
        const int col0 = colt + wc * 32 + 8 * fq;
#pragma unroll
        for (int ai = 0; ai < 2; ++ai)
#pragma unroll
            for (int m = 0; m < 4; ++m) { bf16_t* rowp = base + (size_t)(row0 + ai * 128 + m * 16) * ld + col0;
#pragma unroll
                for (int bj = 0; bj < 2; ++bj) { f32x4 v0 = acc[ai][bj][m][0], v1 = acc[ai][bj][m][1];
                    if (sig) {
#pragma unroll
                        for (int j = 0; j < 4; ++j) { v0[j] = sigmoidf_(v0[j]); v1[j] = sigmoidf_(v1[j]); } }
                    u32x4 w; w.x = pack2(v0[0], v0[1]); w.y = pack2(v0[2], v0[3]); w.z = pack2(v1[0], v1[1]); w.w = pack2(v1[2], v1[3]);
                    *(u32x4*)(rowp + bj * 128) = w; } }
    }
};
struct EpiVG8 {
    static constexpr bool PERM = true, AFTER_DRAIN = false;
    bf16_t* sqkv; unsigned char* g8;
    __device__ __forceinline__ void operator()(const f32x4 (&acc)[2][2][4][2], const pg8::Unit& u, int wr, int wc, int fr, int fq) const {
        const int row0 = u.pm * 256 + wr * 64 + fr;
        if (u.pn < 18) { const int col0 = u.pn * 256 + wc * 32 + 8 * fq;
#pragma unroll
            for (int ai = 0; ai < 2; ++ai)
#pragma unroll
                for (int m = 0; m < 4; ++m) { bf16_t* rowp = sqkv + (size_t)(row0 + ai * 128 + m * 16) * 4608 + col0;
#pragma unroll
                    for (int bj = 0; bj < 2; ++bj) { const f32x4 v0 = acc[ai][bj][m][0] * (1.0f / 256.0f), v1 = acc[ai][bj][m][1] * (1.0f / 256.0f);
                        *(u32x4*)(rowp + bj * 128) = (u32x4){pack2(v0[0], v0[1]), pack2(v0[2], v0[3]), pack2(v1[0], v1[1]), pack2(v1[2], v1[3])}; } }
            return; }
        const int col0 = (u.pn - 18) * 256 + wc * 32 + 8 * fq;
#pragma unroll
        for (int ai = 0; ai < 2; ++ai)
#pragma unroll
            for (int m = 0; m < 4; ++m) { unsigned char* rowp = g8 + (size_t)(row0 + ai * 128 + m * 16) * 4096 + col0;
#pragma unroll
                for (int bj = 0; bj < 2; ++bj) { const f32x4 v0 = acc[ai][bj][m][0], v1 = acc[ai][bj][m][1]; unsigned lo = 0u, hi = 0u;
#pragma unroll
                    for (int j = 0; j < 4; ++j) { lo |= (unsigned)(sigmoidf_(v0[j] * (1.0f / 256.0f)) * 255.0f + 0.5f) << (8 * j); hi |= (unsigned)(sigmoidf_(v1[j] * (1.0f / 256.0f)) * 255.0f + 0.5f) << (8 * j); }
                    *(u32x2*)(rowp + bj * 128) = (u32x2){lo, hi}; } }
    }
};
struct EpiGate8 {
    static constexpr bool PERM = true, AFTER_DRAIN = false;
    unsigned char* g8;
    __device__ __forceinline__ void operator()(const f32x4 (&acc)[2][2][4][2], const pg8::Unit& u, int wr, int wc, int fr, int fq) const {
        const int row0 = u.pm * 256 + wr * 64 + fr, col0 = u.pn * 256 + wc * 32 + 8 * fq;
#pragma unroll
        for (int ai = 0; ai < 2; ++ai)
#pragma unroll
            for (int m = 0; m < 4; ++m) { unsigned char* rowp = g8 + (size_t)(row0 + ai * 128 + m * 16) * 4096 + col0;
#pragma unroll
                for (int bj = 0; bj < 2; ++bj) { const f32x4 v0 = acc[ai][bj][m][0], v1 = acc[ai][bj][m][1]; unsigned lo = 0u, hi = 0u;
#pragma unroll
                    for (int j = 0; j < 4; ++j) { lo |= (unsigned)(sigmoidf_(v0[j] * (1.0f / 256.0f)) * 255.0f + 0.5f) << (8 * j); hi |= (unsigned)(sigmoidf_(v1[j] * (1.0f / 256.0f)) * 255.0f + 0.5f) << (8 * j); }
                    *(u32x2*)(rowp + bj * 128) = (u32x2){lo, hi}; } }
    }
};
struct EpiMix {
    static constexpr bool PERM = true, AFTER_DRAIN = false;
    const unsigned char* gates; int goff; bf16_t* mixed; int first;
    __device__ __forceinline__ void operator()(const f32x4 (&acc)[2][2][4][2], const pg8::Unit& u, int wr, int wc, int fr, int fq) const {
        const int row0 = u.pm * 256 + wr * 64 + fr, col0 = u.pn * 256 + wc * 32 + 8 * fq;
#pragma unroll
        for (int ai = 0; ai < 2; ++ai) {
            u32x2 g[4][2]; u32x4 o[4][2];
#pragma unroll
            for (int m = 0; m < 4; ++m)
#pragma unroll
                for (int bj = 0; bj < 2; ++bj) { const size_t row = (size_t)(row0 + ai * 128 + m * 16); const int col = col0 + bj * 128;
                    g[m][bj] = *(const u32x2*)(gates + row * 4096 + goff + col); o[m][bj] = first ? (u32x4){0u, 0u, 0u, 0u} : *(const u32x4*)(mixed + row * DM + col); }
#pragma unroll
            for (int m = 0; m < 4; ++m)
#pragma unroll
                for (int bj = 0; bj < 2; ++bj) { const size_t row = (size_t)(row0 + ai * 128 + m * 16); const int col = col0 + bj * 128;
                    f32x4 v0 = acc[ai][bj][m][0], v1 = acc[ai][bj][m][1]; const u32x2 gg = g[m][bj]; const u32x4 oo = o[m][bj]; const float s8 = 1.0f / 255.0f;
                    v0[0] = v0[0] * ((float)(gg.x & 0xffu) * s8) + bflo(oo.x); v0[1] = v0[1] * ((float)((gg.x >> 8) & 0xffu) * s8) + bfhi(oo.x); v0[2] = v0[2] * ((float)((gg.x >> 16) & 0xffu) * s8) + bflo(oo.y); v0[3] = v0[3] * ((float)(gg.x >> 24) * s8) + bfhi(oo.y);
                    v1[0] = v1[0] * ((float)(gg.y & 0xffu) * s8) + bflo(oo.z); v1[1] = v1[1] * ((float)((gg.y >> 8) & 0xffu) * s8) + bfhi(oo.z); v1[2] = v1[2] * ((float)((gg.y >> 16) & 0xffu) * s8) + bflo(oo.w); v1[3] = v1[3] * ((float)(gg.y >> 24) * s8) + bfhi(oo.w);
                    u32x4 w; w.x = pack2(v0[0], v0[1]); w.y = pack2(v0[2], v0[3]); w.z = pack2(v1[0], v1[1]); w.w = pack2(v1[2], v1[3]);
                    *(u32x4*)(mixed + row * DM + col) = w; }
        }
    }
};
struct EpiRes {
    static constexpr bool PERM = false, AFTER_DRAIN = false;
    const float* base; float* out;
    __device__ __forceinline__ void operator()(const f32x4 (&acc)[2][2][4][2], const pg8::Unit& u, int wr, int wc, int fr, int fq) const {
        const int row0 = u.pm * 256 + wr * 64 + fr, col0 = u.pn * 256 + wc * 32 + 4 * fq;
#pragma unroll
        for (int ai = 0; ai < 2; ++ai) {
            f32x4 b[4][2][2];
#pragma unroll
            for (int m = 0; m < 4; ++m)
#pragma unroll
                for (int bj = 0; bj < 2; ++bj)
#pragma unroll
                    for (int n = 0; n < 2; ++n) b[m][bj][n] = *(const f32x4*)(base + (size_t)(row0 + ai * 128 + m * 16) * DM + col0 + bj * 128 + n * 16);
#pragma unroll
            for (int m = 0; m < 4; ++m)
#pragma unroll
                for (int bj = 0; bj < 2; ++bj)
#pragma unroll
                    for (int n = 0; n < 2; ++n) *(f32x4*)(out + (size_t)(row0 + ai * 128 + m * 16) * DM + col0 + bj * 128 + n * 16) = b[m][bj][n] + acc[ai][bj][m][n];
        }
    }
};
struct EpiResB {
    static constexpr bool PERM = false, AFTER_DRAIN = false;
    const bf16_t* base; float* out;
    __device__ __forceinline__ void operator()(const f32x4 (&acc)[2][2][4][2], const pg8::Unit& u, int wr, int wc, int fr, int fq) const {
        const int row0 = u.pm * 256 + wr * 64 + fr, col0 = u.pn * 256 + wc * 32 + 4 * fq;
#pragma unroll
        for (int ai = 0; ai < 2; ++ai) {
            u32x2 b[4][2][2];
#pragma unroll
            for (int m = 0; m < 4; ++m)
#pragma unroll
                for (int bj = 0; bj < 2; ++bj)
#pragma unroll
                    for (int n = 0; n < 2; ++n) b[m][bj][n] = *(const u32x2*)(base + (size_t)(row0 + ai * 128 + m * 16) * DM + col0 + bj * 128 + n * 16);
#pragma unroll
            for (int m = 0; m < 4; ++m)
#pragma unroll
                for (int bj = 0; bj < 2; ++bj)
#pragma unroll
                    for (int n = 0; n < 2; ++n) { const u32x2 bb = b[m][bj][n]; const f32x4 xv = {bflo(bb.x), bfhi(bb.x), bflo(bb.y), bfhi(bb.y)};
                        *(f32x4*)(out + (size_t)(row0 + ai * 128 + m * 16) * DM + col0 + bj * 128 + n * 16) = xv + acc[ai][bj][m][n]; }
        }
    }
};
struct EpiOut {
    static constexpr bool PERM = false, AFTER_DRAIN = false;
    const float* base; float* out; bf16_t* x1b; float* rowss;
    __device__ __forceinline__ void operator()(const f32x4 (&acc)[2][2][4][2], const pg8::Unit& u, int wr, int wc, int fr, int fq) const {
        const int row0 = u.pm * 256 + wr * 64 + fr, col0 = u.pn * 256 + wc * 32 + 4 * fq;
#pragma unroll
        for (int ai = 0; ai < 2; ++ai) {
            f32x4 b[4][2][2];
#pragma unroll
            for (int m = 0; m < 4; ++m)
#pragma unroll
                for (int bj = 0; bj < 2; ++bj)
#pragma unroll
                    for (int n = 0; n < 2; ++n) b[m][bj][n] = *(const f32x4*)(base + (size_t)(row0 + ai * 128 + m * 16) * DM + col0 + bj * 128 + n * 16);
#pragma unroll
            for (int m = 0; m < 4; ++m) { const int row = row0 + ai * 128 + m * 16; const size_t off = (size_t)row * DM + col0; float ss = 0.f;
#pragma unroll
                for (int bj = 0; bj < 2; ++bj)
#pragma unroll
                    for (int n = 0; n < 2; ++n) { const f32x4 v = b[m][bj][n] + acc[ai][bj][m][n];
                        *(u32x2*)(x1b + off + bj * 128 + n * 16) = (u32x2){pack2(v[0], v[1]), pack2(v[2], v[3])}; ss += v[0] * v[0] + v[1] * v[1] + v[2] * v[2] + v[3] * v[3]; }
                ss += __shfl_xor(ss, 16); ss += __shfl_xor(ss, 32);
                if (fq == 0) atomicAdd(rowss + row, ss); }
        }
    }
};
struct EpiRelu2 {
    static constexpr bool PERM = true, AFTER_DRAIN = false;
    bf16_t* U; const float* rowss;
    __device__ __forceinline__ void operator()(const f32x4 (&acc)[2][2][4][2], const pg8::Unit& u, int wr, int wc, int fr, int fq) const {
        const int row0 = u.pm * 256 + wr * 64 + fr, col0 = u.pn * 256 + wc * 32 + 8 * fq;
        float rsv[2][4];
#pragma unroll
        for (int ai = 0; ai < 2; ++ai)
#pragma unroll
            for (int m = 0; m < 4; ++m) rsv[ai][m] = rowss[row0 + ai * 128 + m * 16];
#pragma unroll
        for (int ai = 0; ai < 2; ++ai)
#pragma unroll
            for (int m = 0; m < 4; ++m) { const int row = row0 + ai * 128 + m * 16; bf16_t* rowp = U + (size_t)row * DFF + col0;
                const float rs = __builtin_amdgcn_rsqf(rsv[ai][m] * (1.0f / DM) + EPS);
#pragma unroll
                for (int bj = 0; bj < 2; ++bj) { f32x4 v0 = acc[ai][bj][m][0], v1 = acc[ai][bj][m][1];
#pragma unroll
                    for (int j = 0; j < 4; ++j) { const float a = fmaxf(v0[j] * rs, 0.f), b = fmaxf(v1[j] * rs, 0.f); v0[j] = a * a; v1[j] = b * b; }
                    u32x4 w; w.x = pack2(v0[0], v0[1]); w.y = pack2(v0[2], v0[3]); w.z = pack2(v1[0], v1[1]); w.w = pack2(v1[2], v1[3]);
                    *(u32x4*)(rowp + bj * 128) = w; } }
    }
};
struct ListOrder {
    int nM, nN, nwg, first, stride, count;
    __device__ void init(int M, int N, int first_, int stride_, int count_) { nM = M / pg8::BM; nN = N / pg8::BM; nwg = nM * nN; first = first_; stride = stride_; count = count_; }
    __device__ bool next(int i, pg8::Unit& u) const {
        if (i >= count) return false; const int L = first + i * stride; if (L >= nwg) return false;
        int wgid = L; { const int q = nwg / pg8::NXCD, r = nwg % pg8::NXCD, xcd = wgid % pg8::NXCD, off = wgid / pg8::NXCD; wgid = (xcd < r ? xcd * (q + 1) : r * (q + 1) + (xcd - r) * q) + off; }
        const int nig = pg8::WGM * nN, gid = wgid / nig, fm = gid * pg8::WGM, gsz = (nM - fm) < pg8::WGM ? (nM - fm) : pg8::WGM;
        u.pm = fm + ((wgid % nig) % gsz); u.pn = (wgid % nig) / gsz; return true;
    }
    __device__ __forceinline__ void a_ready(const pg8::Unit&) const {}
    __device__ __forceinline__ void done(const pg8::Unit&) const {}
};
template <class Epi> __device__ __forceinline__ void run_gemm_list(LAS unsigned char* lds, const bf16_t* A, const bf16_t* Bt, int M, int N, int K, const Epi& E, int first, int stride, int count) {
    pg8::Gemm g{A, Bt, M, N, K}; ListOrder S; S.init(M, N, first, stride, count);
    pg8::gemm_phase<Epi, ListOrder, false>(lds, g, S, E, nullptr);
}
template <class Epi> __device__ __forceinline__ void run_gemm_f8(LAS unsigned char* lds, const void* A8, const void* Bt8, int M, int N, int Kbytes, const Epi& E, int G, int c) {
    pg8::Gemm g{(const bf16_t*)A8, (const bf16_t*)Bt8, M, N, Kbytes / 2}; pg8::StaticOrder S; S.init(M, N, G, c);
    pg8::gemm_phase<Epi, pg8::StaticOrder, false, true>(lds, g, S, E, nullptr);
}
template <class Epi> __device__ __forceinline__ void run_gemm_sub(LAS unsigned char* lds, const bf16_t* A, const bf16_t* Bt, int M, int N, int K, const Epi& E, int G, int c) {
    pg8::Gemm g{A, Bt, M, N, K}; pg8::StaticOrder S; S.init(M, N, G, c);
    pg8::gemm_phase<Epi, pg8::StaticOrder, false>(lds, g, S, E, nullptr);
}
template <class Epi> __device__ __forceinline__ void run_gemm(LAS unsigned char* lds, const bf16_t* A, const bf16_t* Bt, int M, int N, int K, const Epi& E) {
    pg8::Gemm g{A, Bt, M, N, K}; pg8::StaticOrder S; S.init(M, N, (int)gridDim.x, (int)blockIdx.x);
    pg8::gemm_phase<Epi, pg8::StaticOrder, false>(lds, g, S, E, nullptr);
}

constexpr int KROW = 136;
typedef short s16x4 __attribute__((ext_vector_type(4)));
__device__ __forceinline__ void phase_swa_attn(const Params& p, LAS unsigned char* lds, int ctr_idx = 0) {
    const bf16_t* sq = (const bf16_t*)(p.ws + WS_SQKV); bf16_t* og = (bf16_t*)(p.ws + WS_OG); float* lse_out = (float*)(p.ws + WS_LSE); const f32x4* tab = (const f32x4*)(p.ws + WS_ROPE);
    LAS bf16_t* Ks = (LAS bf16_t*)lds; LAS bf16_t* Vs = Ks + 256 * KROW;
    const int tid = threadIdx.x, w = tid >> 6, lane = tid & 63, m = lane & 15, quad = lane >> 4;
    unsigned* ctr = (unsigned*)(p.ws + WS_CTR) + ctr_idx; LAS int* s_task = (LAS int*)(lds + LDS_BYTES - 16);
    const int kpart = tid & 15;
    float kw[8], kwp[8];
#pragma unroll
    for (int j = 0; j < 8; ++j) { kw[j] = p.in[10][8 * kpart + j]; kwp[j] = p.in[10][8 * (kpart ^ 8) + j]; }
    for (;;) {
        lds_barrier(); if (tid == 0) *s_task = (int)atomicAdd(ctr, 1u); lds_barrier(); const int item = *s_task; if (item >= 768) break;
        const int b = item / 384; int rem = item % 384; const int g = rem / 128; rem %= 128; const int hh = rem / 32, idx = rem % 32;
        const int dil = 1 << (2 * g), nrun = 32 >> (2 * g), r = idx / nrun, lblk0 = (idx % nrun) * 4, head = g * 4 + hh;
        for (int it = 0; it < 4; ++it) {
            const int lblk = lblk0 + it, l0 = lblk * 128;
            if (it) lds_barrier();
            const int nload = (it == 0) ? 2 : 1;
            for (int ld = 0; ld < nload; ++ld) {
                const int blk = (it == 0) ? lblk - 1 + ld : lblk, slot = blk & 1;
                u32x4 kv[4], vv[4]; f32x4 cs[4][4];
#pragma unroll
                for (int i = 0; i < 4; ++i) { const int ch = tid + NTHREADS * i, c = ch >> 4, lk = blk * 128 + c; kv[i] = (u32x4){0u, 0u, 0u, 0u}; vv[i] = kv[i];
#pragma unroll
                    for (int j = 0; j < 4; ++j) cs[i][j] = (f32x4){0.f, 0.f, 0.f, 0.f};
                    if (lk >= 0) { const size_t tok = (size_t)(b * SEQ + lk * dil + r); const bf16_t* rowp = sq + tok * 4608 + head * 128 + kpart * 8; kv[i] = *(const u32x4*)(rowp + 1536); vv[i] = *(const u32x4*)(rowp + 3072);
                        const f32x4* tp = tab + tok * 32 + 4 * (kpart & 7);
#pragma unroll
                        for (int j = 0; j < 4; ++j) cs[i][j] = tp[j]; } }
#pragma unroll
                for (int i = 0; i < 4; ++i) { const int ch = tid + NTHREADS * i, c = ch >> 4, row = slot * 128 + c;
                    float x[8], px[8];
                    x[0] = bflo(kv[i].x); x[1] = bfhi(kv[i].x); x[2] = bflo(kv[i].y); x[3] = bfhi(kv[i].y); x[4] = bflo(kv[i].z); x[5] = bfhi(kv[i].z); x[6] = bflo(kv[i].w); x[7] = bfhi(kv[i].w);
                    float ss = 0.f;
#pragma unroll
                    for (int j = 0; j < 8; ++j) ss += x[j] * x[j];
                    ss += __shfl_xor(ss, 1); ss += __shfl_xor(ss, 2); ss += __shfl_xor(ss, 4); ss += __shfl_xor(ss, 8);
                    const float rr = __builtin_amdgcn_rsqf(ss * (1.0f / 128.0f) + EPS);
                    const unsigned p0 = __shfl_xor(kv[i].x, 8), p1 = __shfl_xor(kv[i].y, 8), p2 = __shfl_xor(kv[i].z, 8), p3 = __shfl_xor(kv[i].w, 8);
                    px[0] = bflo(p0); px[1] = bfhi(p0); px[2] = bflo(p1); px[3] = bfhi(p1); px[4] = bflo(p2); px[5] = bfhi(p2); px[6] = bflo(p3); px[7] = bfhi(p3);
                    const float sgn = (kpart < 8) ? -1.f : 1.f; float o[8];
#pragma unroll
                    for (int j = 0; j < 8; ++j) { const float co = cs[i][j >> 1][2 * (j & 1)], si = cs[i][j >> 1][2 * (j & 1) + 1]; const float y = x[j] * rr * kw[j], py = px[j] * rr * kwp[j]; o[j] = y * co + sgn * py * si; }
                    *(LAS u32x4*)(Ks + row * KROW + kpart * 8) = (u32x4){pack2(o[0], o[1]), pack2(o[2], o[3]), pack2(o[4], o[5]), pack2(o[6], o[7])};
                    *(LAS u32x4*)(Vs + row * KROW + kpart * 8) = vv[i]; }
            }
            const int qtok = b * SEQ + (l0 + 16 * w + m) * dil + r;
            u32x4 qf[4];
            {   u32x4 qr_[4];
#pragma unroll
                for (int ks = 0; ks < 4; ++ks) qr_[ks] = *(const u32x4*)(sq + (size_t)qtok * 4608 + head * 128 + ks * 32 + quad * 8);
                float x[4][8]; float ss = 0.f;
#pragma unroll
                for (int ks = 0; ks < 4; ++ks) { x[ks][0] = bflo(qr_[ks].x); x[ks][1] = bfhi(qr_[ks].x); x[ks][2] = bflo(qr_[ks].y); x[ks][3] = bfhi(qr_[ks].y); x[ks][4] = bflo(qr_[ks].z); x[ks][5] = bfhi(qr_[ks].z); x[ks][6] = bflo(qr_[ks].w); x[ks][7] = bfhi(qr_[ks].w);
#pragma unroll
                    for (int j = 0; j < 8; ++j) ss += x[ks][j] * x[ks][j]; }
                ss += __shfl_xor(ss, 16); ss += __shfl_xor(ss, 32);
                const float rr = (0.08838834764831845f * __builtin_amdgcn_rsqf(ss * (1.0f / 128.0f) + EPS));
                float o[4][8];
#pragma unroll
                for (int ks = 0; ks < 2; ++ks) { const f32x4* tp = tab + (size_t)qtok * 32 + 16 * ks + 4 * quad;
#pragma unroll
                    for (int j4 = 0; j4 < 4; ++j4) { const f32x4 c4 = tp[j4];
#pragma unroll
                        for (int jj = 0; jj < 2; ++jj) { const int j = 2 * j4 + jj, d = 32 * ks + 8 * quad + j; const float co = c4[2 * jj], si = c4[2 * jj + 1];
                            const float y = x[ks][j] * rr * p.in[9][d], py = x[ks + 2][j] * rr * p.in[9][d + 64]; o[ks][j] = y * co - py * si; o[ks + 2][j] = py * co + y * si; } } }
#pragma unroll
                for (int ks = 0; ks < 4; ++ks) qf[ks] = (u32x4){pack2(o[ks][0], o[ks][1]), pack2(o[ks][2], o[ks][3]), pack2(o[ks][4], o[ks][5]), pack2(o[ks][6], o[ks][7])};
            }
            lds_barrier();
#define KROWBASE(kb) (((((lblk - 1 + ((kb) >> 3)) & 1) << 7) + 16 * ((kb) & 7)))
            f32x4 sc[10]; float mx = -3e38f;
#pragma unroll
            for (int t = 0; t < 9; ++t) { const int kb = w + t, rb = KROWBASE(kb); f32x4 acc = {0.f, 0.f, 0.f, 0.f};
#pragma unroll
                for (int ks = 0; ks < 4; ++ks) { const u32x4 a = *(const LAS u32x4*)(Ks + (rb + m) * KROW + ks * 32 + quad * 8); acc = mfma16(a, qf[ks], acc); }
#pragma unroll
                for (int j = 0; j < 4; ++j) { const int kk = 4 * quad + j; bool ok = (l0 > 0) || (16 * kb + kk >= 128);
                    if (t == 0) ok = ok && (kk >= m); if (t == 8) ok = ok && (kk <= m);
                    acc[j] = ok ? acc[j] : -1e30f; mx = fmaxf(mx, acc[j]); }
                sc[t] = acc; }
            mx = fmaxf(mx, __shfl_xor(mx, 16)); mx = fmaxf(mx, __shfl_xor(mx, 32));
            float sum = 0.f;
#pragma unroll
            for (int t = 0; t < 9; ++t)
#pragma unroll
                for (int j = 0; j < 4; ++j) { const float e = __expf(sc[t][j] - mx); sc[t][j] = e; sum += e; }
            sc[9] = (f32x4){0.f, 0.f, 0.f, 0.f};
            sum += __shfl_xor(sum, 16); sum += __shfl_xor(sum, 32);
            const float inv = 1.0f / sum;
            u32x4 Pb[5];
#pragma unroll
            for (int u = 0; u < 5; ++u) Pb[u] = (u32x4){pack2(sc[2 * u][0], sc[2 * u][1]), pack2(sc[2 * u][2], sc[2 * u][3]), pack2(sc[2 * u + 1][0], sc[2 * u + 1][1]), pack2(sc[2 * u + 1][2], sc[2 * u + 1][3])};
            bf16_t* op = og + ((size_t)g * T + qtok) * 512 + hh * 128 + 4 * quad;
            const int qr = m >> 2, pp = m & 3;
#pragma unroll
            for (int db = 0; db < 8; ++db) { f32x4 acc = {0.f, 0.f, 0.f, 0.f};
#pragma unroll
                for (int u = 0; u < 5; ++u) { const int kb0 = w + 2 * u, kb1 = (kb0 + 1 < 16) ? kb0 + 1 : kb0; const int rb0 = KROWBASE(kb0), rb1 = KROWBASE(kb1);
                    const s16x4 v0 = __builtin_amdgcn_ds_read_tr16_b64_v4i16((LAS s16x4*)(Vs + (rb0 + 4 * quad + qr) * KROW + 16 * db + 4 * pp));
                    const s16x4 v1 = __builtin_amdgcn_ds_read_tr16_b64_v4i16((LAS s16x4*)(Vs + (rb1 + 4 * quad + qr) * KROW + 16 * db + 4 * pp));
                    const u32x2 a0 = __builtin_bit_cast(u32x2, v0), a1 = __builtin_bit_cast(u32x2, v1);
                    acc = mfma16((u32x4){a0.x, a0.y, a1.x, a1.y}, Pb[u], acc); }
                *(u32x2*)(op + 16 * db) = (u32x2){pack2(acc[0] * inv, acc[1] * inv), pack2(acc[2] * inv, acc[3] * inv)}; }
#undef KROWBASE
            if (quad == 0) lse_out[((size_t)g * T + qtok) * 4 + hh] = mx + __logf(sum);
        }
    }
}
__device__ __forceinline__ void phase_swa_combine(const Params& p) {
    const bf16_t* og = (const bf16_t*)(p.ws + WS_OG); const float* lse = (const float*)(p.ws + WS_LSE); bf16_t* ob = (bf16_t*)(p.ws + WS_OB);
    for (int it = blockIdx.x * NTHREADS + threadIdx.x; it < T * 64; it += gridDim.x * NTHREADS) {
        const int tok = it >> 6, hh = (it >> 4) & 3, ch = it & 15;
        const float l0 = lse[((size_t)0 * T + tok) * 4 + hh], l1 = lse[((size_t)1 * T + tok) * 4 + hh], l2 = lse[((size_t)2 * T + tok) * 4 + hh];
        const float m = fmaxf(l0, fmaxf(l1, l2)); float w0 = __expf(l0 - m), w1 = __expf(l1 - m), w2 = __expf(l2 - m); const float inv = 1.0f / (w0 + w1 + w2); w0 *= inv; w1 *= inv; w2 *= inv;
        const size_t off = (size_t)tok * 512 + hh * 128 + ch * 8;
        const u32x4 a = *(const u32x4*)(og + off), b = *(const u32x4*)(og + (size_t)T * 512 + off), c = *(const u32x4*)(og + (size_t)2 * T * 512 + off);
        u32x4 o;
        o.x = pack2(w0 * bflo(a.x) + w1 * bflo(b.x) + w2 * bflo(c.x), w0 * bfhi(a.x) + w1 * bfhi(b.x) + w2 * bfhi(c.x));
        o.y = pack2(w0 * bflo(a.y) + w1 * bflo(b.y) + w2 * bflo(c.y), w0 * bfhi(a.y) + w1 * bfhi(b.y) + w2 * bfhi(c.y));
        o.z = pack2(w0 * bflo(a.z) + w1 * bflo(b.z) + w2 * bflo(c.z), w0 * bfhi(a.z) + w1 * bfhi(b.z) + w2 * bfhi(c.z));
        o.w = pack2(w0 * bflo(a.w) + w1 * bflo(b.w) + w2 * bflo(c.w), w0 * bfhi(a.w) + w1 * bfhi(b.w) + w2 * bfhi(c.w));
        *(u32x4*)(ob + off) = o;
    }
}

constexpr int QROW = 136, TROW = 72, AROW = 68;
constexpr int L_QN = 0, L_KN = L_QN + 64 * QROW * 2, L_VN = L_KN + 64 * QROW * 2, L_AKK = L_VN + 64 * QROW * 2, L_TU = L_AKK + 64 * AROW * 4,
              L_TW = L_TU + 64 * TROW * 2, L_QKM = L_TW + 64 * TROW * 2, L_GS = L_QKM + 64 * TROW * 2, L_BS = L_GS + 256, L_GR = L_BS + 256, L_TF = L_GR + 256, L_AB = L_TF + 64 * AROW * 4, L_PREP_END = L_AB + 64 * 16 * 4;
static_assert(L_PREP_END <= LDS_BYTES, "prep LDS");

__device__ __forceinline__ void gdn_ab_block(const Params& p, LAS unsigned char* lds, int tok0) {
    const bf16_t* H = (const bf16_t*)(p.ws + WS_H); const bf16_t* Wab = (const bf16_t*)(p.ws + WS_WT_IN) + (size_t)3072 * DM;
    LAS float* abs_ = (LAS float*)(lds + L_AB);
    const int tid = threadIdx.x, w = tid >> 6, lane = tid & 63, m = lane & 15, q = lane >> 4;
    lds_barrier();
    if (w < 4) {
        const bf16_t* ap = H + (size_t)(tok0 + 16 * w + m) * DM + q * 8; const bf16_t* bp = Wab + (size_t)m * DM + q * 8;
        f32x4 acc0 = {0.f, 0.f, 0.f, 0.f}, acc1 = {0.f, 0.f, 0.f, 0.f};
#pragma unroll 4
        for (int ks = 0; ks < 64; ks += 2) { const u32x4 a0 = *(const u32x4*)(ap + ks * 32), b0 = *(const u32x4*)(bp + ks * 32), a1 = *(const u32x4*)(ap + ks * 32 + 32), b1 = *(const u32x4*)(bp + ks * 32 + 32);
            acc0 = mfma16(a0, b0, acc0); acc1 = mfma16(a1, b1, acc1); }
#pragma unroll
        for (int j = 0; j < 4; ++j) abs_[(16 * w + 4 * q + j) * 16 + m] = acc0[j] + acc1[j];
    }
    lds_barrier();
}
struct PrepRaw { unsigned x[3][11]; f32x2 cw[3][4]; float a, b; };
__device__ __forceinline__ void gdn_prep_load(const Params& p, int chunk, PrepRaw& R) {
    const bf16_t* graw = (const bf16_t*)(p.ws + WS_GRAW); const float* ab = (const float*)(p.ws + WS_AB); const float* cw = p.in[4];
    const int tid = threadIdx.x, w = tid >> 6, lane = tid & 63;
    const int b = chunk >> 11, h = (chunk >> 8) & 7, n = chunk & 255, t0 = n * 64, tok0 = b * SEQ + t0;
#pragma unroll
    for (int part = 0; part < 3; ++part) { const int col = part * 1024 + h * 128 + 2 * lane;
#pragma unroll
        for (int j = 0; j < 4; ++j) R.cw[part][j] = *(const f32x2*)(cw + j * 3072 + col);
#pragma unroll
        for (int i = 0; i < 11; ++i) { const int tt = w * 8 - 3 + i; R.x[part][i] = (t0 + tt >= 0) ? *(const unsigned*)(graw + (size_t)(tok0 + tt) * 3072 + col) : 0u; } }
    R.a = 0.f; R.b = 0.f;
}
__device__ __forceinline__ void gdn_prep_chunk(const Params& p, LAS unsigned char* lds, int chunk, PrepRaw& R, int next_chunk) {
    const bf16_t* graw = (const bf16_t*)(p.ws + WS_GRAW); const float* ab = (const float*)(p.ws + WS_AB); const float* cw = p.in[4];
    LAS bf16_t* qn = (LAS bf16_t*)(lds + L_QN); LAS bf16_t* kn = (LAS bf16_t*)(lds + L_KN); LAS bf16_t* vn = (LAS bf16_t*)(lds + L_VN);
    LAS float* Akk = (LAS float*)(lds + L_AKK); LAS bf16_t* Tu = (LAS bf16_t*)(lds + L_TU); LAS bf16_t* Tw = (LAS bf16_t*)(lds + L_TW); LAS bf16_t* QKm = (LAS bf16_t*)(lds + L_QKM);
    LAS float* Tf = (LAS float*)(lds + L_TF);
    LAS float* Gs = (LAS float*)(lds + L_GS); LAS float* bs = (LAS float*)(lds + L_BS); LAS float* gr = (LAS float*)(lds + L_GR);
    int tid_ = threadIdx.x; asm volatile("" : "+v"(tid_));
    const int tid = tid_, w = __builtin_amdgcn_readfirstlane(tid >> 6), lane = tid & 63, m = lane & 15, q = lane >> 4;
    const int b = chunk >> 11, h = (chunk >> 8) & 7, n = chunk & 255, t0 = n * 64, tok0 = b * SEQ + t0;
    LAS float* abs_ = (LAS float*)(lds + L_AB);
    float ab_a = 0.f, ab_b = 0.f; if (tid < 64) { ab_a = abs_[tid * 16 + h]; ab_b = abs_[tid * 16 + 8 + h]; }
    lds_barrier();
#pragma unroll
    for (int part = 0; part < 3; ++part) {
        const f32x2 (&cwv)[4] = R.cw[part]; const unsigned (&x)[11] = R.x[part];
#pragma unroll
        for (int k = 0; k < 8; ++k) {
            float y0 = 0.f, y1 = 0.f;
#pragma unroll
            for (int j = 0; j < 4; ++j) { y0 += cwv[j][0] * bflo(x[k + j]); y1 += cwv[j][1] * bfhi(x[k + j]); }
            y0 = siluf_(y0); y1 = siluf_(y1);
            const int tl = w * 8 + k;
            if (part == 0) { const float ss = wave_sum(y0 * y0 + y1 * y1), r = (0.08838834764831845f * __builtin_amdgcn_rsqf(ss + EPS)); *(LAS unsigned*)(qn + tl * QROW + 2 * lane) = pack2(y0 * r, y1 * r); }
            else if (part == 1) { const float ss = wave_sum(y0 * y0 + y1 * y1), r = __builtin_amdgcn_rsqf(ss + EPS); const unsigned pk = pack2(y0 * r, y1 * r);
                *(LAS unsigned*)(kn + tl * QROW + 2 * lane) = pk; }
            else { *(LAS unsigned*)(vn + tl * QROW + 2 * lane) = pack2(y0, y1); }
        }
    }
    if (next_chunk < 4096) gdn_prep_load(p, next_chunk, R);
    if (tid < 64) { const float xx = ab_a + p.in[6][h];
        const float sp = xx > 20.f ? xx : log1pf(expf(xx)); gr[tid] = -expf(p.in[5][h]) * sp; bs[tid] = 1.0f / (1.0f + expf(-ab_b)); }
    lds_barrier();
    if (tid < 64) { float G0 = 0.f, G1 = 0.f, G2 = 0.f, G3 = 0.f; int tq = tid; asm volatile("" : "+v"(tq));
#pragma unroll
        for (int j4 = 0; j4 < 16; ++j4) { const f32x4 gv = *(const LAS f32x4*)(gr + 4 * j4); G0 += (4 * j4 <= tq) ? gv[0] : 0.f; G1 += (4 * j4 + 1 <= tq) ? gv[1] : 0.f; G2 += (4 * j4 + 2 <= tq) ? gv[2] : 0.f; G3 += (4 * j4 + 3 <= tq) ? gv[3] : 0.f; }
        const float G = (G0 + G1) + (G2 + G3); Gs[tid] = G; if (tid == 63) ((float*)(p.ws + WS_GDEC))[chunk] = expf(G); }
    lds_barrier();
    { const int ib = w >> 1;
#pragma unroll
      for (int j2 = 0; j2 < 2; ++j2) { const int jb = 2 * (w & 1) + j2; f32x4 akk = {0.f, 0.f, 0.f, 0.f}, aqk = {0.f, 0.f, 0.f, 0.f};
#pragma unroll
          for (int ks = 0; ks < 4; ++ks) { const u32x4 bf = *(const LAS u32x4*)(kn + (16 * jb + m) * QROW + ks * 32 + q * 8);
              const u32x4 ak = *(const LAS u32x4*)(kn + (16 * ib + m) * QROW + ks * 32 + q * 8), aq = *(const LAS u32x4*)(qn + (16 * ib + m) * QROW + ks * 32 + q * 8);
              akk = mfma16(ak, bf, akk); aqk = mfma16(aq, bf, aqk); }
          const int j = 16 * jb + m; const float Gj = Gs[j];
#pragma unroll
          for (int jj = 0; jj < 4; ++jj) { const int i = 16 * ib + 4 * q + jj; const float dcy = (i >= j) ? __expf(Gs[i] - Gj) : 0.f;
              Akk[i * AROW + j] = (i > j) ? bs[i] * akk[jj] * dcy : 0.f; QKm[i * TROW + j] = f2bf(aqk[jj] * dcy); } } }
    lds_barrier();
    if (w == 0) {
        int c = lane & 31; asm volatile("" : "+v"(c));
        const int bo = (lane >> 5) * 32; float Tc[32];
#pragma unroll
        for (int i = 0; i < 32; ++i) Tc[i] = 0.f;
#pragma unroll
        for (int i = 0; i < 32; ++i) { float s0 = (i == c) ? 1.f : 0.f, s1 = 0.f, s2 = 0.f, s3 = 0.f;
#pragma unroll
            for (int j4 = 0; j4 < (i + 3) / 4; ++j4) { const f32x4 a = *(const LAS f32x4*)(Akk + (bo + i) * AROW + bo + 4 * j4); s0 -= a[0] * Tc[4 * j4]; s1 -= a[1] * Tc[4 * j4 + 1]; s2 -= a[2] * Tc[4 * j4 + 2]; s3 -= a[3] * Tc[4 * j4 + 3]; }
            Tc[i] = (s0 + s1) + (s2 + s3); if ((i & 3) == 3) asm volatile("" ::: "memory"); }
#pragma unroll
        for (int i = 0; i < 32; ++i) Tf[(bo + i) * AROW + bo + c] = Tc[i];
    } else {
        u32x4* AF = (u32x4*)(p.ws + WS_AF) + (size_t)chunk * 512; u32x4* QF = (u32x4*)(p.ws + WS_QF) + (size_t)chunk * 1024; u32x4* KF = (u32x4*)(p.ws + WS_KF) + (size_t)chunk * 1024;
        const float Glast = Gs[63];
        for (int ft = w - 1; ft < 40; ft += 7) {
            if (ft < 8) { const int r = ft >> 1, s2 = ft & 1; const LAS bf16_t* bp = QKm + (16 * r + m) * TROW + 32 * s2 + 4 * q;
                const u32x2 lo = *(const LAS u32x2*)bp, hi = *(const LAS u32x2*)(bp + 16); AF[ft * 64 + lane] = (u32x4){lo.x, lo.y, hi.x, hi.y}; }
            else if (ft < 24) { const int f = ft - 8, r = f >> 2, s = f & 3; const LAS bf16_t* bp = qn + (16 * r + m) * QROW + 32 * s + 4 * q;
                const u32x2 lo = *(const LAS u32x2*)bp, hi = *(const LAS u32x2*)(bp + 16); const float sc = __expf(Gs[16 * r + m]);
                QF[f * 64 + lane] = (u32x4){pack2(bflo(lo.x) * sc, bfhi(lo.x) * sc), pack2(bflo(lo.y) * sc, bfhi(lo.y) * sc), pack2(bflo(hi.x) * sc, bfhi(hi.x) * sc), pack2(bflo(hi.y) * sc, bfhi(hi.y) * sc)}; }
            else { const int f = ft - 24, rd = f >> 1, s2 = f & 1; const int tk = 32 * s2 + 4 * q;
                const u32x2 lo = __builtin_bit_cast(u32x2, __builtin_amdgcn_ds_read_tr16_b64_v4i16((LAS s16x4*)(kn + (tk + (m >> 2)) * QROW + 16 * rd + 4 * (m & 3))));
                const u32x2 hi = __builtin_bit_cast(u32x2, __builtin_amdgcn_ds_read_tr16_b64_v4i16((LAS s16x4*)(kn + (tk + 16 + (m >> 2)) * QROW + 16 * rd + 4 * (m & 3))));
                const float e0 = __expf(Glast - Gs[tk]), e1 = __expf(Glast - Gs[tk + 1]), e2 = __expf(Glast - Gs[tk + 2]), e3 = __expf(Glast - Gs[tk + 3]);
                const float e4 = __expf(Glast - Gs[tk + 16]), e5 = __expf(Glast - Gs[tk + 17]), e6 = __expf(Glast - Gs[tk + 18]), e7 = __expf(Glast - Gs[tk + 19]);
                KF[f * 64 + lane] = (u32x4){pack2(bflo(lo.x) * e0, bfhi(lo.x) * e1), pack2(bflo(lo.y) * e2, bfhi(lo.y) * e3), pack2(bflo(hi.x) * e4, bfhi(hi.x) * e5), pack2(bflo(hi.y) * e6, bfhi(hi.y) * e7)}; }
        }
    }
    lds_barrier();
    {
        const int c = tid & 31, i0 = tid >> 5; float x0 = 0.f, x1 = 0.f;
#pragma unroll
        for (int j4 = 0; j4 < 8; ++j4) { const f32x4 a0 = *(const LAS f32x4*)(Akk + (32 + i0) * AROW + 4 * j4), a1 = *(const LAS f32x4*)(Akk + (48 + i0) * AROW + 4 * j4);
#pragma unroll
            for (int jj = 0; jj < 4; ++jj) { const float t = Tf[(4 * j4 + jj) * AROW + c]; x0 += a0[jj] * t; x1 += a1[jj] * t; } }
        Tf[(32 + i0) * AROW + c] = x0; Tf[(48 + i0) * AROW + c] = x1;
    }
    lds_barrier();
    {
        const int c = tid & 31, i0 = tid >> 5; float y0 = 0.f, y1 = 0.f;
#pragma unroll
        for (int k4 = 0; k4 < 8; ++k4) { const f32x4 a0 = *(const LAS f32x4*)(Tf + (32 + i0) * AROW + 32 + 4 * k4), a1 = *(const LAS f32x4*)(Tf + (48 + i0) * AROW + 32 + 4 * k4);
#pragma unroll
            for (int kk = 0; kk < 4; ++kk) { const float xk = Tf[(32 + 4 * k4 + kk) * AROW + c]; y0 -= a0[kk] * xk; y1 -= a1[kk] * xk; } }
        const float cb0 = bs[c], ce0 = cb0 * __expf(Gs[c]), cb1 = bs[32 + c], ce1 = cb1 * __expf(Gs[32 + c]);
        Tu[(32 + i0) * TROW + c] = f2bf(y0 * cb0); Tw[(32 + i0) * TROW + c] = f2bf(y0 * ce0); Tu[(48 + i0) * TROW + c] = f2bf(y1 * cb0); Tw[(48 + i0) * TROW + c] = f2bf(y1 * ce0);
        const float d00 = Tf[i0 * AROW + c], d01 = Tf[(16 + i0) * AROW + c], d10 = Tf[(32 + i0) * AROW + 32 + c], d11 = Tf[(48 + i0) * AROW + 32 + c];
        Tu[i0 * TROW + c] = f2bf(d00 * cb0); Tw[i0 * TROW + c] = f2bf(d00 * ce0); Tu[(16 + i0) * TROW + c] = f2bf(d01 * cb0); Tw[(16 + i0) * TROW + c] = f2bf(d01 * ce0);
        Tu[(32 + i0) * TROW + 32 + c] = f2bf(d10 * cb1); Tw[(32 + i0) * TROW + 32 + c] = f2bf(d10 * ce1); Tu[(48 + i0) * TROW + 32 + c] = f2bf(d11 * cb1); Tw[(48 + i0) * TROW + 32 + c] = f2bf(d11 * ce1);
        Tu[i0 * TROW + 32 + c] = 0; Tw[i0 * TROW + 32 + c] = 0; Tu[(16 + i0) * TROW + 32 + c] = 0; Tw[(16 + i0) * TROW + 32 + c] = 0;
    }
    lds_barrier();
    { u32x2* UA = (u32x2*)(p.ws + WS_UACC) + (size_t)chunk * 2048; u32x2* WF2 = (u32x2*)(p.ws + WS_WF) + (size_t)chunk * 2048;
#pragma unroll
      for (int r = 0; r < 4; ++r) { f32x4 acc = {0.f, 0.f, 0.f, 0.f};
#pragma unroll
          for (int ks = 0; ks < 2; ++ks) { const u32x4 a = *(const LAS u32x4*)(Tu + (16 * r + m) * TROW + ks * 32 + q * 8);
              const u32x2 b0 = __builtin_bit_cast(u32x2, __builtin_amdgcn_ds_read_tr16_b64_v4i16((LAS s16x4*)(vn + (ks * 32 + 8 * q + (m >> 2)) * QROW + 16 * w + 4 * (m & 3))));
              const u32x2 b1 = __builtin_bit_cast(u32x2, __builtin_amdgcn_ds_read_tr16_b64_v4i16((LAS s16x4*)(vn + (ks * 32 + 8 * q + 4 + (m >> 2)) * QROW + 16 * w + 4 * (m & 3))));
              acc = mfma16(a, (u32x4){b0.x, b0.y, b1.x, b1.y}, acc); }
          UA[(w * 4 + r) * 64 + lane] = (u32x2){pack2(acc[0], acc[1]), pack2(acc[2], acc[3])}; }
#pragma unroll
      for (int ib = 0; ib < 4; ++ib) { f32x4 acc = {0.f, 0.f, 0.f, 0.f};
#pragma unroll
          for (int ks = 0; ks < 2; ++ks) { const u32x4 bb = *(const LAS u32x4*)(Tw + (16 * ib + m) * TROW + ks * 32 + q * 8);
              const u32x2 a0 = __builtin_bit_cast(u32x2, __builtin_amdgcn_ds_read_tr16_b64_v4i16((LAS s16x4*)(kn + (ks * 32 + 8 * q + (m >> 2)) * QROW + 16 * w + 4 * (m & 3))));
              const u32x2 a1 = __builtin_bit_cast(u32x2, __builtin_amdgcn_ds_read_tr16_b64_v4i16((LAS s16x4*)(kn + (ks * 32 + 8 * q + 4 + (m >> 2)) * QROW + 16 * w + 4 * (m & 3))));
              acc = mfma16((u32x4){a0.x, a0.y, a1.x, a1.y}, bb, acc); }
          WF2[((ib * 4 + (w >> 1)) * 64 + lane) * 2 + (w & 1)] = (u32x2){pack2(-acc[0], -acc[1]), pack2(-acc[2], -acc[3])}; } }
}

constexpr int SC_WF = 0, SC_QF = 1024, SC_AF = 2048, SC_KF = 2560, SC_N = 3584;
__device__ __forceinline__ void gdn_scan(const Params& p, LAS unsigned char* lds, int bh) {
    const int tid = threadIdx.x, w = tid >> 6, lane = tid & 63;
    const int cb = bh * 256;
    const u32x4* WFg = (const u32x4*)(p.ws + WS_WF); const u32x4* QFg = (const u32x4*)(p.ws + WS_QF); const u32x4* AFg = (const u32x4*)(p.ws + WS_AF); const u32x4* KFg = (const u32x4*)(p.ws + WS_KF);
    const u32x2* UA = (const u32x2*)(p.ws + WS_UACC); u32x2* OR = (u32x2*)(p.ws + WS_ORAW); const float* gdec = (const float*)(p.ws + WS_GDEC);
    LAS u32x4* buf = (LAS u32x4*)lds;
    lds_barrier();
    if (w >= 4) {
        const int lt = tid - 256; u32x4 rg[14];
#define SC_LOAD(ch) do { const size_t c_ = (size_t)(cb + (ch)); _Pragma("unroll") for (int i_ = 0; i_ < 4; ++i_) { rg[i_] = WFg[c_ * 1024 + i_ * 256 + lt]; rg[4 + i_] = QFg[c_ * 1024 + i_ * 256 + lt]; rg[10 + i_] = KFg[c_ * 1024 + i_ * 256 + lt]; } \
        rg[8] = AFg[c_ * 512 + lt]; rg[9] = AFg[c_ * 512 + 256 + lt]; } while (0)
#define SC_WRITE(bi) do { LAS u32x4* d_ = buf + (bi) * SC_N; _Pragma("unroll") for (int i_ = 0; i_ < 4; ++i_) { d_[SC_WF + i_ * 256 + lt] = rg[i_]; d_[SC_QF + i_ * 256 + lt] = rg[4 + i_]; d_[SC_KF + i_ * 256 + lt] = rg[10 + i_]; } \
        d_[SC_AF + lt] = rg[8]; d_[SC_AF + 256 + lt] = rg[9]; } while (0)
        SC_LOAD(0); SC_WRITE(0); SC_LOAD(1);
        lds_barrier();
        for (int n = 0; n < 256; ++n) {
            if (n + 1 < 256) SC_WRITE((n + 1) & 1);
            if (n + 2 < 256) SC_LOAD(n + 2);
            lds_barrier();
        }
#undef SC_LOAD
#undef SC_WRITE
    } else {
        f32x4 S[8][2]; u32x4 Sbf[4][2];
#pragma unroll
        for (int i = 0; i < 8; ++i) { S[i][0] = (f32x4){0.f, 0.f, 0.f, 0.f}; S[i][1] = (f32x4){0.f, 0.f, 0.f, 0.f}; }
#pragma unroll
        for (int i = 0; i < 4; ++i) { Sbf[i][0] = (u32x4){0u, 0u, 0u, 0u}; Sbf[i][1] = (u32x4){0u, 0u, 0u, 0u}; }
        u32x2 ub[2][4]; float dec;
#pragma unroll
        for (int nb = 0; nb < 2; ++nb)
#pragma unroll
            for (int r = 0; r < 4; ++r) ub[nb][r] = UA[(size_t)cb * 2048 + ((2 * w + nb) * 4 + r) * 64 + lane];
        dec = gdec[cb];
        lds_barrier();
        for (int n = 0; n < 256; ++n) {
            const LAS u32x4* B = buf + (n & 1) * SC_N;
            f32x4 vn[4][2], o[4][2];
#pragma unroll
            for (int r = 0; r < 4; ++r)
#pragma unroll
                for (int nb = 0; nb < 2; ++nb) { const u32x2 u = ub[nb][r]; vn[r][nb] = (f32x4){bflo(u.x), bfhi(u.x), bflo(u.y), bfhi(u.y)}; o[r][nb] = (f32x4){0.f, 0.f, 0.f, 0.f}; }
            const float dcur = dec;
            { const int nn = (n + 1 < 256) ? n + 1 : n;
#pragma unroll
              for (int nb = 0; nb < 2; ++nb)
#pragma unroll
                  for (int r = 0; r < 4; ++r) ub[nb][r] = UA[(size_t)(cb + nn) * 2048 + ((2 * w + nb) * 4 + r) * 64 + lane];
              dec = gdec[cb + nn]; }
            asm volatile("" ::: "memory");
#pragma unroll
            for (int r = 0; r < 4; ++r)
#pragma unroll
                for (int s = 0; s < 4; ++s) { const u32x4 aw = B[SC_WF + (r * 4 + s) * 64 + lane], aq = B[SC_QF + (r * 4 + s) * 64 + lane];
                    vn[r][0] = mfma16(aw, Sbf[s][0], vn[r][0]); vn[r][1] = mfma16(aw, Sbf[s][1], vn[r][1]);
                    o[r][0] = mfma16(aq, Sbf[s][0], o[r][0]); o[r][1] = mfma16(aq, Sbf[s][1], o[r][1]); }
            u32x4 Vb[2][2];
#pragma unroll
            for (int s2 = 0; s2 < 2; ++s2)
#pragma unroll
                for (int nb = 0; nb < 2; ++nb) Vb[s2][nb] = (u32x4){pack2(vn[2 * s2][nb][0], vn[2 * s2][nb][1]), pack2(vn[2 * s2][nb][2], vn[2 * s2][nb][3]), pack2(vn[2 * s2 + 1][nb][0], vn[2 * s2 + 1][nb][1]), pack2(vn[2 * s2 + 1][nb][2], vn[2 * s2 + 1][nb][3])};
#pragma unroll
            for (int r = 0; r < 4; ++r)
#pragma unroll
                for (int s2 = 0; s2 < 2; ++s2) { const u32x4 a = B[SC_AF + (r * 2 + s2) * 64 + lane]; o[r][0] = mfma16(a, Vb[s2][0], o[r][0]); o[r][1] = mfma16(a, Vb[s2][1], o[r][1]); }
#pragma unroll
            for (int nb = 0; nb < 2; ++nb)
#pragma unroll
                for (int r = 0; r < 4; ++r) OR[(size_t)(cb + n) * 2048 + ((2 * w + nb) * 4 + r) * 64 + lane] = (u32x2){pack2(o[r][nb][0], o[r][nb][1]), pack2(o[r][nb][2], o[r][nb][3])};
            asm volatile("" ::: "memory");
#pragma unroll
            for (int rd = 0; rd < 8; ++rd) { S[rd][0] *= dcur; S[rd][1] *= dcur;
#pragma unroll
                for (int s2 = 0; s2 < 2; ++s2) { const u32x4 a = B[SC_KF + (rd * 2 + s2) * 64 + lane]; S[rd][0] = mfma16(a, Vb[s2][0], S[rd][0]); S[rd][1] = mfma16(a, Vb[s2][1], S[rd][1]); } }
#pragma unroll
            for (int s = 0; s < 4; ++s)
#pragma unroll
                for (int nb = 0; nb < 2; ++nb) Sbf[s][nb] = (u32x4){pack2(S[2 * s][nb][0], S[2 * s][nb][1]), pack2(S[2 * s][nb][2], S[2 * s][nb][3]), pack2(S[2 * s + 1][nb][0], S[2 * s + 1][nb][1]), pack2(S[2 * s + 1][nb][2], S[2 * s + 1][nb][3])};
            lds_barrier();
        }
    }
}
__device__ __forceinline__ void phase_gdn_norm(const Params& p, LAS unsigned char* lds) {
    const u32x2* OR = (const u32x2*)(p.ws + WS_ORAW); const bf16_t* z = (const bf16_t*)(p.ws + WS_Z); bf16_t* oa = (bf16_t*)(p.ws + WS_OA); const float* nw = p.in[7];
    const int lane = threadIdx.x & 63, w = threadIdx.x >> 6, m = lane & 15, q = lane >> 4, gw = blockIdx.x * 8 + w, nwv_ = gridDim.x * 8;
    LAS bf16_t* tile = (LAS bf16_t*)lds + w * (16 * QROW);
    const int tl = lane >> 2, eq = lane & 3;
    float nwv[32];
#pragma unroll
    for (int i = 0; i < 32; ++i) nwv[i] = nw[32 * eq + i];
    for (int it = gw; it < 4096 * 4; it += nwv_) {
        const int chunk = it >> 2, r = it & 3; const int b = chunk >> 11, h = (chunk >> 8) & 7, n = chunk & 255;
        const size_t off = ((size_t)b * SEQ + n * 64 + 16 * r + tl) * 1024 + h * 128 + 32 * eq;
        u32x4 zz[4];
#pragma unroll
        for (int i = 0; i < 4; ++i) zz[i] = *(const u32x4*)(z + off + 8 * i);
#pragma unroll
        for (int eb = 0; eb < 8; ++eb) { const u32x2 u = OR[(size_t)chunk * 2048 + (eb * 4 + r) * 64 + lane]; LAS bf16_t* tp = tile + (4 * q) * QROW + 16 * eb + m;
            tp[0] = (bf16_t)(u.x & 0xffffu); tp[QROW] = (bf16_t)(u.x >> 16); tp[2 * QROW] = (bf16_t)(u.y & 0xffffu); tp[3 * QROW] = (bf16_t)(u.y >> 16); }
        asm volatile("s_waitcnt lgkmcnt(0)" ::: "memory");
        u32x4 oo[4];
#pragma unroll
        for (int i = 0; i < 4; ++i) oo[i] = *(const LAS u32x4*)(tile + tl * QROW + 32 * eq + 8 * i);
        float ov[32]; float ss = 0.f;
#pragma unroll
        for (int i = 0; i < 4; ++i) { ov[8 * i] = bflo(oo[i].x); ov[8 * i + 1] = bfhi(oo[i].x); ov[8 * i + 2] = bflo(oo[i].y); ov[8 * i + 3] = bfhi(oo[i].y); ov[8 * i + 4] = bflo(oo[i].z); ov[8 * i + 5] = bfhi(oo[i].z); ov[8 * i + 6] = bflo(oo[i].w); ov[8 * i + 7] = bfhi(oo[i].w); }
#pragma unroll
        for (int i = 0; i < 32; ++i) ss += ov[i] * ov[i];
        ss += __shfl_xor(ss, 1); ss += __shfl_xor(ss, 2); const float rs = __builtin_amdgcn_rsqf(ss * (1.0f / 128.0f) + EPS);
#pragma unroll
        for (int i = 0; i < 4; ++i) { const unsigned zw[4] = {zz[i].x, zz[i].y, zz[i].z, zz[i].w}; unsigned ow[4];
#pragma unroll
            for (int k = 0; k < 4; ++k) ow[k] = pack2(ov[8 * i + 2 * k] * rs * nwv[8 * i + 2 * k] * siluf_(bflo(zw[k])), ov[8 * i + 2 * k + 1] * rs * nwv[8 * i + 2 * k + 1] * siluf_(bfhi(zw[k])));
            *(u32x4*)(oa + off + 8 * i) = (u32x4){ow[0], ow[1], ow[2], ow[3]}; }
        asm volatile("s_waitcnt lgkmcnt(0)" ::: "memory");
    }
    lds_barrier();
}
constexpr int NPHASE = 10;
__global__ void __launch_bounds__(NTHREADS, 2) mega(Params p) {
    extern __shared__ __attribute__((aligned(16))) unsigned char lds_raw[];
    LAS unsigned char* lds = (LAS unsigned char*)lds_raw;
    cg::grid_group grid = cg::this_grid();
    unsigned char* ws = p.ws;
    const int lo = p.ph_lo, hi = p.ph_hi;
    const int G = (int)gridDim.x, bx = (int)blockIdx.x;
#define IN(k) (lo <= (k) && (k) < hi)
#define SEAM(k) do { if (IN(k) && IN((k) + 1)) grid.sync(); } while (0)
    if (IN(0)) { phase_prep(p, lds); } SEAM(0);
    if (IN(1)) { EpiIn E{(bf16_t*)(ws + WS_GRAW), (bf16_t*)(ws + WS_Z), (bf16_t*)(ws + WS_SQKV), (bf16_t*)p.out, (float*)(ws + WS_AB), 0};
        run_gemm_sub(lds, (const bf16_t*)(ws + WS_H), (const bf16_t*)(ws + WS_WT_IN), T, 3072, DM, E, G, bx); } SEAM(1);
    if (IN(2)) { PrepRaw R;
        if (bx < 512) gdn_prep_load(p, ((bx >> 8) * 8) * 256 + (bx & 255), R);
        for (int tb = bx; tb < 512; tb += G) { const int b = tb >> 8, n = tb & 255;
            gdn_ab_block(p, lds, b * SEQ + n * 64);
            for (int h = 0; h < 8; ++h) { const int chunk = (b * 8 + h) * 256 + n;
                int nxt = 4096; if (h < 7) nxt = chunk + 256; else if (tb + G < 512) { const int t2 = tb + G; nxt = ((t2 >> 8) * 8) * 256 + (t2 & 255); }
                gdn_prep_chunk(p, lds, chunk, R, nxt); } } } SEAM(2);
    if (IN(3)) { const int ns = G > 32 ? 16 : 0;
        if (bx < ns || ns == 0) { for (int bh = bx; bh < 16; bh += (ns ? ns : G)) gdn_scan(p, lds, bh); }
        if (bx >= ns) {
            { EpiIn E{(bf16_t*)(ws + WS_GRAW), (bf16_t*)(ws + WS_Z), (bf16_t*)(ws + WS_SQKV), nullptr, (float*)(ws + WS_AB), 13};
              run_gemm_sub(lds, (const bf16_t*)(ws + WS_H), (const bf16_t*)(ws + WS_WT_IN) + (size_t)IN_A_ROWS * DM, T, 4 * 256, DM, E, G - ns, bx - ns); }
            { EpiVG8 E{(bf16_t*)(ws + WS_SQKV), (unsigned char*)p.out + OUT_G8};
              run_gemm_f8(lds, (const unsigned char*)p.out + OUT_H8, ws + WS_WG8, T, 8704, DM, E, G - ns, (bx - ns + (G - ns) / 2) % (G - ns)); } } } SEAM(3);
    if (IN(4)) { phase_gdn_norm(p, lds); phase_swa_attn(p, lds); } SEAM(4);
    if (IN(5)) { phase_swa_combine(p); } SEAM(5);
    if (IN(6)) { { EpiMix E{(const unsigned char*)p.out + OUT_G8, 0, (bf16_t*)(ws + WS_MIXED), 1}; run_gemm_sub(lds, (const bf16_t*)(ws + WS_OA), (const bf16_t*)(ws + WS_WT_GDN), T, DM, 1024, E, G, bx); }
                 { EpiMix E{(const unsigned char*)p.out + OUT_G8, 2048, (bf16_t*)(ws + WS_MIXED), 0}; run_gemm_sub(lds, (const bf16_t*)(ws + WS_OB), (const bf16_t*)(ws + WS_WT_SWA), T, DM, 512, E, G, bx); } } SEAM(6);
    if (IN(7)) { EpiOut E{p.in[0], p.out, (bf16_t*)(ws + WS_X1B), (float*)(ws + WS_ROWSS)}; run_gemm_sub(lds, (const bf16_t*)(ws + WS_MIXED), (const bf16_t*)(ws + WS_WT_OUT), T, DM, DM, E, G, bx); } SEAM(7);
    if (IN(8)) { EpiRelu2 E{(bf16_t*)(ws + WS_U), (const float*)(ws + WS_ROWSS)}; run_gemm_sub(lds, (const bf16_t*)(ws + WS_X1B), (const bf16_t*)(ws + WS_WT_FF1), T, DFF, DM, E, G, bx); } SEAM(8);
    if (IN(9)) { EpiResB E{(const bf16_t*)(ws + WS_X1B), p.out}; run_gemm_sub(lds, (const bf16_t*)(ws + WS_U), (const bf16_t*)(ws + WS_WT_FF2), T, DM, DFF, E, G, bx); }
#undef IN
#undef SEAM
}

#ifndef ONE_LAUNCH
#define ONE_LAUNCH 1
#endif
extern "C" void kernel_launch(void* const* d_in, const int* in_sizes, int n_in, void* d_out, int out_size, void* d_ws, size_t ws_size, hipStream_t stream) {
    if (n_in != 16 || ws_size < WS_END || out_size != T * DM) { fprintf(stderr, "kernel_launch: unexpected shapes (n_in %d ws %zu out %d)\n", n_in, ws_size, out_size); return; }
    static int grid = 0;
    if (grid == 0) { int dev = 0, cus = 0; (void)hipGetDevice(&dev); (void)hipDeviceGetAttribute(&cus, hipDeviceAttributeMultiprocessorCount, dev); grid = cus > 0 ? cus : 256; }
    (void)hipFuncSetAttribute((const void*)mega, hipFuncAttributeMaxDynamicSharedMemorySize, LDS_BYTES);
    Params p{};
    for (int i = 0; i < 16; ++i) p.in[i] = (const float*)d_in[i];
    p.out = (float*)d_out; p.ws = (unsigned char*)d_ws;
#if ONE_LAUNCH
    p.ph_lo = 0; p.ph_hi = NPHASE;
    void* args[] = {&p};
    hipError_t e = hipLaunchCooperativeKernel((const void*)mega, dim3(grid), dim3(NTHREADS), args, LDS_BYTES, stream);
    if (e != hipSuccess) fprintf(stderr, "cooperative launch failed: %s (grid %d)\n", hipGetErrorString(e), grid);
#else
    for (int ph = 0; ph < NPHASE; ++ph) { p.ph_lo = ph; p.ph_hi = ph + 1; hipLaunchKernelGGL(mega, dim3(grid), dim3(NTHREADS), LDS_BYTES, stream, p); }
#endif
}
```
